# Optimizing an MI355X kernel written in HIP

```python
import jax, jax.numpy as jnp
from jax import lax
import numpy as np

D_MODEL = 1024
BATCH = 1
SEQ = 16384
DEPTH = 1
DEC_BATCH = 32
DEC_SEQ = 16
PAST_LEN = 4096

CHUNK = 64
N_META = 16
RET_WIDTH = D_MODEL // 2
RET_HEADS = 4
HEAD_DIM = RET_WIDTH // RET_HEADS
CONV_WIDTH = D_MODEL - RET_WIDTH
CONV_K = 31
D_FF = 4 * D_MODEL
N_IN = 4 * RET_WIDTH + 2 * CONV_WIDTH
EPS = 1e-6
ROPE_BASE = 10000.0

kernel_name = "hymba_retention_conformer_stream"


def rms_norm(x, g):
    xf = x.astype(jnp.float32)
    y = xf * lax.rsqrt(jnp.mean(xf * xf, axis=-1, keepdims=True) + EPS)
    return (y * g.astype(jnp.float32)).astype(x.dtype)


def layer_norm(x, g, b):
    xf = x.astype(jnp.float32)
    mu = jnp.mean(xf, axis=-1, keepdims=True)
    var = jnp.mean(jnp.square(xf - mu), axis=-1, keepdims=True)
    y = (xf - mu) * lax.rsqrt(var + EPS)
    return (y * g.astype(jnp.float32) + b.astype(jnp.float32)).astype(x.dtype)


def rope(x, pos):
    half = HEAD_DIM // 2
    inv = ROPE_BASE ** (-jnp.arange(half, dtype=jnp.float32) / half)
    ang = pos.astype(jnp.float32)[:, None] * inv[None, :]
    cos = jnp.cos(ang)[None, :, None, :]
    sin = jnp.sin(ang)[None, :, None, :]
    xf = x.astype(jnp.float32)
    x1, x2 = xf[..., :half], xf[..., half:]
    return jnp.concatenate([x1 * cos - x2 * sin, x2 * cos + x1 * sin], axis=-1).astype(x.dtype)


def log_gamma():
    return jnp.log1p(-jnp.exp2(-5.0 - jnp.arange(RET_HEADS, dtype=jnp.float32)))


def retention_block(q, k, v, S):
    q = q.astype(jnp.float32)
    k = k.astype(jnp.float32)
    v = v.astype(jnp.float32)
    S = S.astype(jnp.float32)
    L = q.shape[1]
    lg = log_gamma()
    idx = jnp.arange(L, dtype=jnp.float32)
    d_intra = jnp.exp(lg[:, None, None] * jnp.abs(idx[:, None] - idx[None, :]))
    d_in = jnp.exp(lg[None, :] * (idx[:, None] + 1.0))
    d_out = jnp.exp(lg[:, None] * (L - 1.0 - idx[None, :]))
    scores = jnp.einsum('bihd,bjhd->bhij', q, k) * d_intra[None]
    intra = jnp.einsum('bhij,bjhe->bihe', scores, v)
    inter = jnp.einsum('bihd,bhde->bihe', q, S) * d_in[None, :, :, None]
    S_new = S * jnp.exp(lg * L)[None, :, None, None] + jnp.einsum('bjhd,bjhe,hj->bhde', k, v, d_out)
    return intra + inter, S_new


def retention_prompt(q, k, v):
    B, T = q.shape[:2]
    n_pad = (-T) % CHUNK
    padw = ((0, 0), (n_pad, 0), (0, 0), (0, 0))
    nc = (T + n_pad) // CHUNK

    def blocks(a):
        a = jnp.pad(a.astype(jnp.float32), padw)
        return a.reshape(B, nc, CHUNK, RET_HEADS, HEAD_DIM).transpose(1, 0, 2, 3, 4)

    def body(S, blk):
        qb, kb, vb = blk
        o, S = retention_block(qb, kb, vb, S)
        return S, o

    S0 = jnp.zeros((B, RET_HEADS, HEAD_DIM, HEAD_DIM), jnp.float32)
    S_fin, o = lax.scan(body, S0, (blocks(q), blocks(k), blocks(v)))
    o = o.transpose(1, 0, 2, 3, 4).reshape(B, nc * CHUNK, RET_HEADS, HEAD_DIM)[:, n_pad:]
    return o, S_fin


def mixer_inputs(x, pos, g_pre, w_in):
    B, T = x.shape[:2]
    h = rms_norm(x, g_pre)
    proj = h @ w_in
    q, k, v, gate, ga, gb = jnp.split(
        proj, [RET_WIDTH, 2 * RET_WIDTH, 3 * RET_WIDTH, 4 * RET_WIDTH, 4 * RET_WIDTH + CONV_WIDTH], axis=-1)
    q = rope(q.reshape(B, T, RET_HEADS, HEAD_DIM), pos)
    k = rope(k.reshape(B, T, RET_HEADS, HEAD_DIM), pos) * (HEAD_DIM ** -0.5)
    v = v.reshape(B, T, RET_HEADS, HEAD_DIM)
    u = ga * jax.nn.sigmoid(gb)
    return q, k, v, gate, u


def conv_module(u, buf, dw_w, dw_b, ln_g, ln_b):
    ext = jnp.concatenate([buf.astype(u.dtype), u], axis=1)
    y = lax.conv_general_dilated(ext, dw_w[:, None, :].astype(u.dtype), window_strides=(1,), padding='VALID',
                                 dimension_numbers=('NWC', 'WIO', 'NWC'),
                                 feature_group_count=CONV_WIDTH) + dw_b
    y = jax.nn.silu(layer_norm(y, ln_g, ln_b))
    return y, ext[:, -(CONV_K - 1):]


def mixer_outputs(x, ret, gate, u, conv_buf, gn_g, gn_b, dw_w, dw_b, cln_g, cln_b, w_out, g_post_mix,
                  g_pre_mlp, w_mlp_in, w_mlp_out, g_post_mlp):
    B, T = x.shape[:2]
    mu = jnp.mean(ret, axis=-1, keepdims=True)
    var = jnp.mean(jnp.square(ret - mu), axis=-1, keepdims=True)
    rn = ((ret - mu) * lax.rsqrt(var + EPS)).reshape(B, T, RET_WIDTH)
    rn = (rn * gn_g.astype(jnp.float32) + gn_b.astype(jnp.float32)).astype(x.dtype)
    ret_out = rn * jax.nn.silu(gate)
    conv_out, new_buf = conv_module(u, conv_buf, dw_w, dw_b, cln_g, cln_b)
    mix = jnp.concatenate([ret_out, conv_out.astype(x.dtype)], axis=-1) @ w_out
    x = x + rms_norm(mix, g_post_mix)
    h = rms_norm(x, g_pre_mlp)
    f = jnp.square(jax.nn.relu(h @ w_mlp_in)) @ w_mlp_out
    x = x + rms_norm(f, g_post_mlp)
    return x, new_buf


def setup_inputs(seed: int = 0) -> dict:
    key = jax.random.key(seed)
    ks = jax.random.split(key, 19)
    f32 = jnp.float32

    def nrm(k, shape, scale):
        return jax.random.normal(k, shape, f32) * scale

    def gain(k, shape):
        return 1.0 + 0.05 * jax.random.normal(k, shape, f32)

    return {
        "x_prompt": nrm(ks[0], (BATCH, SEQ, D_MODEL), 1.0),
        "x_sample": nrm(ks[1], (DEC_BATCH, DEC_SEQ, D_MODEL), 1.0),
        "state_ret": nrm(ks[2], (DEPTH, DEC_BATCH, RET_HEADS, HEAD_DIM, HEAD_DIM), 0.5),
        "cache_conv": nrm(ks[3], (DEPTH, DEC_BATCH, CONV_K - 1, CONV_WIDTH), 0.5),
        "meta": nrm(ks[4], (N_META, D_MODEL), 1.0),
        "g_pre_mix": gain(ks[5], (DEPTH, D_MODEL)),
        "w_in": nrm(ks[6], (DEPTH, D_MODEL, N_IN), D_MODEL ** -0.5),
        "gn_g": gain(ks[7], (DEPTH, RET_WIDTH)),
        "gn_b": nrm(ks[8], (DEPTH, RET_WIDTH), 0.02),
        "dw_w": nrm(ks[9], (DEPTH, CONV_K, CONV_WIDTH), CONV_K ** -0.5),
        "dw_b": nrm(ks[10], (DEPTH, CONV_WIDTH), 0.02),
        "cln_g": gain(ks[11], (DEPTH, CONV_WIDTH)),
        "cln_b": nrm(ks[12], (DEPTH, CONV_WIDTH), 0.02),
        "w_out": nrm(ks[13], (DEPTH, RET_WIDTH + CONV_WIDTH, D_MODEL), (RET_WIDTH + CONV_WIDTH) ** -0.5),
        "g_post_mix": gain(ks[14], (DEPTH, D_MODEL)),
        "g_pre_mlp": gain(ks[15], (DEPTH, D_MODEL)),
        "w_mlp_in": nrm(ks[16], (DEPTH, D_MODEL, D_FF), D_MODEL ** -0.5),
        "w_mlp_out": nrm(ks[17], (DEPTH, D_FF, D_MODEL), D_FF ** -0.5),
        "g_post_mlp": gain(ks[18], (DEPTH, D_MODEL)),
    }


def reference(x_prompt, x_sample, state_ret, cache_conv, meta, g_pre_mix, w_in, gn_g, gn_b, dw_w, dw_b,
              cln_g, cln_b, w_out, g_post_mix, g_pre_mlp, w_mlp_in, w_mlp_out, g_post_mlp):
    B = x_prompt.shape[0]
    meta_b = jnp.broadcast_to(meta[None].astype(x_prompt.dtype), (B, N_META, D_MODEL))
    xp = jnp.concatenate([meta_b, x_prompt], axis=1)
    xs = x_sample
    pos_p = jnp.arange(xp.shape[1], dtype=jnp.int32)
    pos_s = N_META + PAST_LEN + jnp.arange(xs.shape[1], dtype=jnp.int32)
    ret_p_list, conv_p_list, ret_s_list, conv_s_list = [], [], [], []
    for l in range(DEPTH):
        wts = (gn_g[l], gn_b[l], dw_w[l], dw_b[l], cln_g[l], cln_b[l], w_out[l], g_post_mix[l],
               g_pre_mlp[l], w_mlp_in[l], w_mlp_out[l], g_post_mlp[l])
        q, k, v, gate, u = mixer_inputs(xp, pos_p, g_pre_mix[l], w_in[l])
        ret, S_p = retention_prompt(q, k, v)
        zero_buf = jnp.zeros((B, CONV_K - 1, CONV_WIDTH), u.dtype)
        xp, buf_p = mixer_outputs(xp, ret, gate, u, zero_buf, *wts)
        q, k, v, gate, u = mixer_inputs(xs, pos_s, g_pre_mix[l], w_in[l])
        ret, S_s = retention_block(q, k, v, state_ret[l])
        xs, buf_s = mixer_outputs(xs, ret, gate, u, cache_conv[l], *wts)
        ret_p_list.append(S_p.astype(x_prompt.dtype))
        conv_p_list.append(buf_p)
        ret_s_list.append(S_s.astype(x_sample.dtype))
        conv_s_list.append(buf_s)
    y_prompt = xp[:, N_META:]
    return (y_prompt, xs, jnp.stack(ret_p_list), jnp.stack(conv_p_list), jnp.stack(ret_s_list), jnp.stack(conv_s_list))
```

```cpp
#include <hip/hip_runtime.h>
#include <hip/hip_cooperative_groups.h>
#include <cstdio>
#include <cstdint>
namespace cg = cooperative_groups;
namespace pg8 {
#define PG8_LAS __attribute__((address_space(3)))
typedef unsigned short bf16_t;
typedef short bf16x8 __attribute__((ext_vector_type(8)));
typedef float f32x4 __attribute__((ext_vector_type(4)));
typedef unsigned u32x4 __attribute__((ext_vector_type(4)));
constexpr int BM = 256, BK = 64, HALF = 128, HTB = HALF * BK * 2  , STAGE_BYTES = 8 * HTB, NXCD = 8, WGM = 8;

__host__ __device__ __forceinline__ int lds_byte(int r, int c) { const int st = (r >> 4) * 2 + (c >> 5), rr = r & 15, cc = c & 31, ob = rr * 64 + cc * 2; return st * 1024 + (ob ^ (((ob >> 9) & 1) << 5)); }
__host__ __device__ __forceinline__ void stage_rc(int b, int& R, int& C) { const int st = b / 1024, sb = b % 1024, swz = sb ^ (((sb >> 9) & 1) << 5); R = (st >> 1) * 16 + swz / 64; C = (st & 1) * 32 + (swz % 64) / 2; }
__host__ __device__ __forceinline__ int perm32(int rho) { const int n = rho >> 4, i = rho & 15; return 8 * (i >> 2) + 4 * n + (i & 3); }

struct Unit { int pm, pn; };
struct Gemm { const bf16_t* A; const bf16_t* Bt; int M, N, K; };

struct StaticOrder {
    int nM, nN, nwg, G, c;
    __host__ __device__ void init(int M, int N, int G_, int c_) { nM = M / BM; nN = N / BM; nwg = nM * nN; G = G_; c = c_; }
    __host__ __device__ bool next(int i, Unit& u) const {
        const long L = (long)i * G + c; if (L >= nwg) return false;
        int wgid = (int)L; { const int q = nwg / NXCD, r = nwg % NXCD, xcd = wgid % NXCD, off = wgid / NXCD; wgid = (xcd < r ? xcd * (q + 1) : r * (q + 1) + (xcd - r) * q) + off; }
        const int nig = WGM * nN, gid = wgid / nig, fm = gid * WGM, gsz = (nM - fm) < WGM ? (nM - fm) : WGM;
        u.pm = fm + ((wgid % nig) % gsz); u.pn = (wgid % nig) / gsz; return true;
    }
    __device__ __forceinline__ void a_ready(const Unit&) const {}
    __device__ __forceinline__ void done(const Unit&) const {}
};

__device__ __forceinline__ unsigned cvt_pk_bf16(float lo, float hi) { unsigned r; asm volatile("v_cvt_pk_bf16_f32 %0, %1, %2" : "=v"(r) : "v"(lo), "v"(hi)); return r; }
template <class Epi, class Sched, bool ALIGN_EPI = false, bool SP2 = false>
__device__ __forceinline__ void gemm_phase(PG8_LAS unsigned char* lds, const Gemm g, const Sched& S, const Epi& E) {
    const int tid = threadIdx.x, wid = __builtin_amdgcn_readfirstlane(tid >> 6), lane = tid & 63, wr = wid >> 2, wc = wid & 3, fr = lane & 15, fq = lane >> 4;
    const int K = g.K, nt = K / BK;
    unsigned voffA[2], voffB[2];
#pragma unroll
    for (int i = 0; i < 2; ++i) { int R, C; stage_rc(tid * 16 + i * 8192, R, C); const int Rb = Epi::PERM ? ((R & ~31) + perm32(R & 31)) : R;
        voffA[i] = (unsigned)(R * K + C) * 2u; voffB[i] = (unsigned)(Rb * K + C) * 2u; }
    const size_t kstep = (size_t)(BK * 2);
    const size_t hstep = (size_t)HALF * K * 2;
    const size_t tstep = 2 * hstep;
    const unsigned ldsw = (unsigned)wid * 1024u;
    const int aoff = lds_byte(wr * 64 + fr, fq * 8), boff = lds_byte(wc * 32 + fr, fq * 8);
#define PG8_SA(b, h) (((b) * 2 + (h)) * HTB)
#define PG8_SB(b, h) ((4 + (b) * 2 + (h)) * HTB)
#define PG8_STAGE(bufoff, gbase, voff) do { _Pragma("unroll") for (int _i = 0; _i < 2; ++_i) \
        __builtin_amdgcn_global_load_lds((const unsigned*)((const char*)(gbase) + (voff)[_i]), (PG8_LAS unsigned*)(lds + (bufoff) + ldsw + _i * 8192), 16, 0, 0); } while (0)
#define PG8_LDA(dst, b, h) do { _Pragma("unroll") for (int m = 0; m < 4; ++m) _Pragma("unroll") for (int k = 0; k < 2; ++k) dst[m][k] = *(const PG8_LAS bf16x8*)(lds + PG8_SA(b, h) + aoff + m * 2048 + k * 1024); } while (0)
#define PG8_LDB(dst, b, h) do { _Pragma("unroll") for (int n = 0; n < 2; ++n) _Pragma("unroll") for (int k = 0; k < 2; ++k) dst[n][k] = *(const PG8_LAS bf16x8*)(lds + PG8_SB(b, h) + boff + n * 2048 + k * 1024); } while (0)
#define PG8_MMA(ai, bj, At, Bt) do { __builtin_amdgcn_s_setprio(1); _Pragma("unroll") for (int m = 0; m < 4; ++m) _Pragma("unroll") for (int n = 0; n < 2; ++n) _Pragma("unroll") for (int k = 0; k < 2; ++k) \
        acc[ai][bj][m][n] = __builtin_amdgcn_mfma_f32_16x16x32_bf16(Bt[n][k], At[m][k], acc[ai][bj][m][n], 0, 0, 0); __builtin_amdgcn_s_setprio(0); } while (0)
#define PG8_WAIT_V(n) asm volatile("s_waitcnt vmcnt(" #n ")" ::: "memory")
#define PG8_WAIT_L(n) asm volatile("s_waitcnt lgkmcnt(" #n ")" ::: "memory")
#define PG8_BAR __builtin_amdgcn_s_barrier()
#define PG8_SCHED __builtin_amdgcn_sched_barrier(0)
    Unit cur, nxt; int ui = 0;
    if (!S.next(0, cur)) return;
    f32x4 acc[2][2][4][2];
#pragma unroll
    for (int a = 0; a < 2; ++a)
#pragma unroll
        for (int b = 0; b < 2; ++b)
#pragma unroll
            for (int m = 0; m < 4; ++m)
#pragma unroll
                for (int n = 0; n < 2; ++n) acc[a][b][m][n] = (f32x4){0.f, 0.f, 0.f, 0.f};
    bf16x8 At[4][2], B0[2][2], B1[2][2];
    const char* cA = (const char*)g.A + (size_t)cur.pm * tstep; const char* cB = (const char*)g.Bt + (size_t)cur.pn * tstep;
    S.a_ready(cur);
    if constexpr (SP2) {
        PG8_STAGE(PG8_SB(0, 0), cB, voffB); PG8_STAGE(PG8_SB(0, 1), cB + hstep, voffB); PG8_STAGE(PG8_SA(0, 0), cA, voffA); PG8_STAGE(PG8_SA(0, 1), cA + hstep, voffA);
        if (wr == 1) PG8_BAR;
        PG8_WAIT_V(2); PG8_BAR;
        PG8_STAGE(PG8_SB(1, 0), cB + kstep, voffB); PG8_STAGE(PG8_SA(1, 0), cA + kstep, voffA); PG8_STAGE(PG8_SB(1, 1), cB + hstep + kstep, voffB);
        PG8_WAIT_V(6); PG8_BAR;
    } else {
        PG8_STAGE(PG8_SB(0, 0), cB, voffB); PG8_STAGE(PG8_SA(0, 0), cA, voffA); PG8_STAGE(PG8_SB(0, 1), cB + hstep, voffB); PG8_STAGE(PG8_SA(0, 1), cA + hstep, voffA);
        if (wr == 1) PG8_BAR;
        PG8_WAIT_V(4); PG8_BAR;
        PG8_STAGE(PG8_SB(1, 0), cB + kstep, voffB); PG8_STAGE(PG8_SA(1, 0), cA + kstep, voffA); PG8_STAGE(PG8_SB(1, 1), cB + hstep + kstep, voffB);
        PG8_WAIT_V(6); PG8_BAR;
    }
    for (;;) {
        const bool has_next = S.next(ui + 1, nxt);
        const char* nA = has_next ? (const char*)g.A + (size_t)nxt.pm * tstep : cA; const char* nB = has_next ? (const char*)g.Bt + (size_t)nxt.pn * tstep : cB;
        for (int t = 0; t < nt; t += 2) {
            const bool last = (t == nt - 2);
            const char* a1 = cA + (size_t)(t + 1) * kstep;
            const char* a2 = last ? nA : cA + (size_t)(t + 2) * kstep; const char* b2 = last ? nB : cB + (size_t)(t + 2) * kstep;
            const char* a3 = a2 + kstep; const char* b3 = b2 + kstep;
            if (last && has_next) S.a_ready(nxt);
            if constexpr (SP2) {
            PG8_LDB(B0, 0, 0); PG8_LDB(B1, 0, 1); PG8_SCHED; PG8_LDA(At, 0, 0); PG8_STAGE(PG8_SA(1, 1), a1 + hstep, voffA);
            PG8_WAIT_V(8); PG8_WAIT_L(0); PG8_BAR; PG8_MMA(0, 0, At, B0); PG8_MMA(0, 1, At, B1); PG8_BAR; PG8_SCHED;
            PG8_LDA(At, 0, 1); PG8_STAGE(PG8_SB(0, 0), b2, voffB); PG8_STAGE(PG8_SB(0, 1), b2 + hstep, voffB); PG8_STAGE(PG8_SA(0, 0), a2, voffA);
            PG8_WAIT_V(8); PG8_WAIT_L(0); PG8_BAR; PG8_MMA(1, 0, At, B0); PG8_MMA(1, 1, At, B1); PG8_BAR; PG8_SCHED;
            PG8_LDB(B0, 1, 0); PG8_LDB(B1, 1, 1); PG8_SCHED; PG8_LDA(At, 1, 0); PG8_STAGE(PG8_SA(0, 1), a2 + hstep, voffA);
            PG8_WAIT_V(8); PG8_WAIT_L(0); PG8_BAR; PG8_MMA(0, 0, At, B0); PG8_MMA(0, 1, At, B1); PG8_BAR; PG8_SCHED;
            PG8_LDA(At, 1, 1); PG8_STAGE(PG8_SB(1, 0), b3, voffB); PG8_STAGE(PG8_SB(1, 1), b3 + hstep, voffB); PG8_STAGE(PG8_SA(1, 0), a3, voffA);
            PG8_WAIT_V(8); PG8_WAIT_L(0); PG8_BAR; PG8_MMA(1, 0, At, B0); PG8_MMA(1, 1, At, B1); PG8_BAR; PG8_SCHED;
            } else {
            PG8_LDB(B0, 0, 0); PG8_SCHED; PG8_LDA(At, 0, 0); PG8_STAGE(PG8_SA(1, 1), a1 + hstep, voffA);
            PG8_WAIT_L(8); PG8_BAR; PG8_WAIT_L(0); PG8_MMA(0, 0, At, B0); PG8_BAR; PG8_SCHED;
            PG8_LDB(B1, 0, 1); PG8_STAGE(PG8_SB(0, 0), b2, voffB);
            PG8_BAR; PG8_WAIT_L(0); PG8_MMA(0, 1, At, B1); PG8_BAR;
            PG8_LDA(At, 0, 1); PG8_STAGE(PG8_SA(0, 0), a2, voffA);
            PG8_BAR; PG8_WAIT_L(0); PG8_MMA(1, 0, At, B0); PG8_BAR; PG8_SCHED;
            PG8_STAGE(PG8_SB(0, 1), b2 + hstep, voffB);
            PG8_WAIT_V(6); PG8_BAR; PG8_MMA(1, 1, At, B1); PG8_BAR;
            PG8_LDB(B0, 1, 0); PG8_SCHED; PG8_LDA(At, 1, 0); PG8_STAGE(PG8_SA(0, 1), a2 + hstep, voffA);
            PG8_WAIT_L(8); PG8_BAR; PG8_WAIT_L(0); PG8_MMA(0, 0, At, B0); PG8_BAR; PG8_SCHED;
            PG8_LDB(B1, 1, 1); PG8_STAGE(PG8_SB(1, 0), b3, voffB);
            PG8_BAR; PG8_WAIT_L(0); PG8_MMA(0, 1, At, B1); PG8_BAR;
            PG8_LDA(At, 1, 1); PG8_STAGE(PG8_SA(1, 0), a3, voffA);
            PG8_BAR; PG8_WAIT_L(0); PG8_MMA(1, 0, At, B0); PG8_BAR; PG8_SCHED;
            PG8_STAGE(PG8_SB(1, 1), b3 + hstep, voffB);
            PG8_WAIT_V(6); PG8_BAR; PG8_MMA(1, 1, At, B1); PG8_BAR;
            }
        }
        if constexpr (ALIGN_EPI) { if (wr == 0) PG8_BAR; }
        if constexpr (!Epi::AFTER_DRAIN) { E(acc, cur, wr, wc, fr, fq); S.done(cur); }
        if (!has_next) break;
#pragma unroll
        for (int a = 0; a < 2; ++a)
#pragma unroll
            for (int b = 0; b < 2; ++b)
#pragma unroll
                for (int m = 0; m < 4; ++m)
#pragma unroll
                    for (int n = 0; n < 2; ++n) acc[a][b][m][n] = (f32x4){0.f, 0.f, 0.f, 0.f};
        cur = nxt; cA = nA; cB = nB; ++ui;
        if constexpr (ALIGN_EPI) { if (wr == 1) PG8_BAR; }
    }
    PG8_WAIT_V(0);
    if constexpr (!ALIGN_EPI) { if (wr == 0) PG8_BAR; }
    PG8_BAR;
    if constexpr (Epi::AFTER_DRAIN) { E.fused(acc, cur, wr, wc, fr, fq, lds, wid, lane); S.done(cur); }
#undef PG8_SA
#undef PG8_SB
#undef PG8_STAGE
#undef PG8_LDA
#undef PG8_LDB
#undef PG8_MMA
#undef PG8_WAIT_V
#undef PG8_WAIT_L
#undef PG8_BAR
#undef PG8_SCHED
}
}
#define GAS __attribute__((address_space(1)))
#define LAS __attribute__((address_space(3)))
typedef unsigned short bf16;
typedef unsigned v4u __attribute__((ext_vector_type(4)));
typedef unsigned v2u __attribute__((ext_vector_type(2)));
typedef float f32x4 __attribute__((ext_vector_type(4)));
typedef short bf16x8 __attribute__((ext_vector_type(8)));

constexpr int NWAVES = 8, NT = 512;
constexpr int D = 1024, NIN = 3072, FF = 4096, HD = 128, NH = 4, RW = 512, CW = 512, CK = 31;
constexpr int MMAIN = 16384, ROW_META = 16384, ROW_SMP = 16400, NREAL = 16912, R = 16960, MTAIL = R - MMAIN;
constexpr int NCH = 289;
constexpr float EPS = 1e-6f;
constexpr size_t MiB = 1u << 20;
constexpr size_t WS_WIN = 1 * MiB, WS_WOUT = 7 * MiB, WS_WMI = 9 * MiB, WS_WMO = 17 * MiB;
constexpr size_t WS_BUFA = 25 * MiB;
constexpr size_t WS_BUFB = 59 * MiB;
constexpr size_t WS_Q = 93 * MiB, WS_K = 110 * MiB, WS_V = 127 * MiB;
constexpr size_t WS_KVT = 144 * MiB;
constexpr size_t WS_ST = 209 * MiB;
constexpr size_t WS_HID = 93 * MiB;
constexpr size_t WS_END = 246 * MiB;
static_assert((size_t)R * 1024 * 2 <= 34 * MiB && (size_t)R * 512 * 2 <= 17 * MiB && (size_t)257 * 4 * 16384 * 4 <= 65 * MiB && (size_t)NCH * 4 * 16384 * 2 <= 37 * MiB && WS_HID + (size_t)R * 4096 * 2 <= WS_END, "ws map");
constexpr size_t O_YP = 0, O_YS = 16777216, O_SP = 17301504, O_CP = 17367040, O_SS = 17382400, O_CS = 19479552;
constexpr int LDS_BYTES = 147456;

__constant__ double c_invturn[64] = {0.15915494309189535, 0.13782250260398285, 0.11934937021124886, 0.10335229661843406, 0.08949940160889101, 0.07750328875537406, 0.06711508300522726, 0.058119267441876246, 0.050329212104487035, 0.04358330210530733, 0.03774158471741977, 0.032682865872357, 0.0283021958306234, 0.024508691862069852, 0.02122365276477766, 0.018378926105679667, 0.015915494309189534, 0.013782250260398284, 0.011934937021124886, 0.010335229661843406, 0.008949940160889102, 0.0077503288755374055, 0.006711508300522725, 0.005811926744187624, 0.005032921210448704, 0.004358330210530733, 0.003774158471741977, 0.0032682865872356993, 0.00283021958306234, 0.002450869186206985, 0.0021223652764777662, 0.0018378926105679667, 0.0015915494309189536, 0.0013782250260398288, 0.0011934937021124885, 0.0010335229661843405, 0.0008949940160889102, 0.0007750328875537405, 0.0006711508300522726, 0.0005811926744187624, 0.0005032921210448703, 0.0004358330210530733, 0.00037741584717419774, 0.0003268286587235699, 0.00028302195830623395, 0.00024508691862069854, 0.0002122365276477766, 0.00018378926105679666, 0.00015915494309189535, 0.00013782250260398286, 0.00011934937021124886, 0.00010335229661843406, 8.949940160889102e-05, 7.750328875537406e-05, 6.711508300522725e-05, 5.811926744187624e-05, 5.0329212104487035e-05, 4.358330210530732e-05, 3.774158471741978e-05, 3.2682865872357e-05, 2.8302195830623396e-05, 2.4508691862069852e-05, 2.122365276477766e-05, 1.8378926105679668e-05};

__device__ __forceinline__ float lg2gamma(int h) { return h == 0 ? -0.04580368961312479f : h == 1 ? -0.02272007650008353f : h == 2 ? -0.011315313227834146f : -0.005646563141142063f; }
__device__ __forceinline__ float ex2(float x) { return __builtin_amdgcn_exp2f(x); }
__device__ __forceinline__ unsigned f2bf(float f) { unsigned u = __builtin_bit_cast(unsigned, f); return (u + 0x7fffu + ((u >> 16) & 1u)) >> 16; }
__device__ __forceinline__ unsigned pk2(float lo, float hi) { return f2bf(lo) | (f2bf(hi) << 16); }
__device__ __forceinline__ float bflo(unsigned w) { return __builtin_bit_cast(float, w << 16); }
__device__ __forceinline__ float bfhi(unsigned w) { return __builtin_bit_cast(float, w & 0xffff0000u); }
__device__ __forceinline__ float bf1(bf16 h) { return __builtin_bit_cast(float, (unsigned)h << 16); }
__device__ __forceinline__ float sigmoidf_(float x) { return 1.0f / (1.0f + __expf(-x)); }
__device__ __forceinline__ float siluf_(float x) { return x / (1.0f + __expf(-x)); }
__device__ __forceinline__ float wave_sum(float v) {
#pragma unroll
    for (int o = 1; o < 64; o <<= 1) v += __shfl_xor(v, o);
    return v;
}
__device__ __forceinline__ int rowpos(int row) { return row < ROW_META ? 16 + row : (row < ROW_SMP ? row - ROW_META : 4112 + ((row - ROW_SMP) & 15)); }
__device__ __forceinline__ int dorig(int dp) { return (dp >> 1) + 64 * (dp & 1); }
__device__ __forceinline__ int win_src_col(int n) {
    if (n < 1024) return (n & ~127) + dorig(n & 127);
    if (n < 2048) return n;
    const int c = (n - 2048) >> 1; return (n & 1) ? 2560 + c : 2048 + c;
}

struct Frame {
    LAS unsigned char* lds;
    int tid, lane, wave, wg, nwg;
    const float *xp, *xs, *state, *cache, *meta, *g_pre_mix, *w_in, *gn_g, *gn_b, *dw_w, *dw_b, *cln_g, *cln_b, *w_out, *g_post_mix, *g_pre_mlp, *w_mi, *w_mo, *g_post_mlp;
    float* out;
    bf16 *Win_t, *Wout_t, *Wmi_t, *Wmo_t, *BufA, *BufB, *Ub, *Gb, *Qb, *Kb, *Vb, *St, *HID;
    float* KVt;
};
__device__ __forceinline__ const float* xrow(const Frame& F, int row) {
    if (row < ROW_META) return F.xp + (size_t)row * D;
    if (row < ROW_SMP) return F.meta + (size_t)(row - ROW_META) * D;
    return F.xs + (size_t)(row - ROW_SMP) * D;
}

struct FStore { bf16* O; int ldc;
    __device__ __forceinline__ void operator()(int row, int col, f32x4 v0, f32x4 v1) const {
        v4u w; w.x = pg8::cvt_pk_bf16(v0[0], v0[1]); w.y = pg8::cvt_pk_bf16(v0[2], v0[3]); w.z = pg8::cvt_pk_bf16(v1[0], v1[1]); w.w = pg8::cvt_pk_bf16(v1[2], v1[3]);
        *(v4u*)(O + (size_t)row * ldc + col) = w; } };
struct FRelu2 { bf16* O; int ldc;
    __device__ __forceinline__ void operator()(int row, int col, f32x4 v0, f32x4 v1) const {
#pragma unroll
        for (int t = 0; t < 4; ++t) { float a = fmaxf(v0[t], 0.f), b = fmaxf(v1[t], 0.f); v0[t] = a * a; v1[t] = b * b; }
        v4u w; w.x = pg8::cvt_pk_bf16(v0[0], v0[1]); w.y = pg8::cvt_pk_bf16(v0[2], v0[3]); w.z = pg8::cvt_pk_bf16(v1[0], v1[1]); w.w = pg8::cvt_pk_bf16(v1[2], v1[3]);
        *(v4u*)(O + (size_t)row * ldc + col) = w; } };
struct FProj { bf16 *Q, *K, *V, *G, *U;
    __device__ __forceinline__ void operator()(int row, int col, f32x4 v0, f32x4 v1) const {
        const int reg = col >> 9;
        float x[8] = {v0[0], v0[1], v0[2], v0[3], v1[0], v1[1], v1[2], v1[3]};
        if (reg < 2) {
            const int cc = col & 511, d0 = (cc & 127) >> 1;
            const double pos = (double)rowpos(row);
            const float sc = reg == 1 ? 0.08838834764831845f : 1.0f;
#pragma unroll
            for (int t = 0; t < 4; ++t) {
                double tu = pos * c_invturn[d0 + t]; tu -= __builtin_rint(tu);
                const float f = (float)tu, s = __builtin_amdgcn_sinf(f), c = __builtin_amdgcn_cosf(f);
                const float x1 = x[2 * t], x2 = x[2 * t + 1];
                x[2 * t] = (x1 * c - x2 * s) * sc; x[2 * t + 1] = (x2 * c + x1 * s) * sc;
            }
            v4u w; w.x = pg8::cvt_pk_bf16(x[0], x[1]); w.y = pg8::cvt_pk_bf16(x[2], x[3]); w.z = pg8::cvt_pk_bf16(x[4], x[5]); w.w = pg8::cvt_pk_bf16(x[6], x[7]);
            *(v4u*)((reg == 0 ? Q : K) + (size_t)row * 512 + cc) = w;
        } else if (reg < 4) {
            const int cc = col & 511;
            if (reg == 3) {
#pragma unroll
                for (int t = 0; t < 8; ++t) x[t] = siluf_(x[t]);
            }
            v4u w; w.x = pg8::cvt_pk_bf16(x[0], x[1]); w.y = pg8::cvt_pk_bf16(x[2], x[3]); w.z = pg8::cvt_pk_bf16(x[4], x[5]); w.w = pg8::cvt_pk_bf16(x[6], x[7]);
            *(v4u*)((reg == 2 ? V : G) + (size_t)row * 512 + cc) = w;
        } else {
            const int c0 = (col - 2048) >> 1;
            float u[4];
#pragma unroll
            for (int t = 0; t < 4; ++t) u[t] = x[2 * t] * sigmoidf_(x[2 * t + 1]);
            v2u w; w.x = pg8::cvt_pk_bf16(u[0], u[1]); w.y = pg8::cvt_pk_bf16(u[2], u[3]);
            *(v2u*)(U + (size_t)row * 512 + c0) = w;
        }
    } };
template <class Fn> struct EpiAd {
    static constexpr bool PERM = true, AFTER_DRAIN = false; Fn f;
    __device__ __forceinline__ void operator()(const f32x4 (&acc)[2][2][4][2], const pg8::Unit& u, int wr, int wc, int fr, int fq) const {
        const int row0 = u.pm * 256 + wr * 64 + fr, col0 = u.pn * 256 + wc * 32 + 8 * fq;
#pragma unroll
        for (int ai = 0; ai < 2; ++ai)
#pragma unroll
            for (int m = 0; m < 4; ++m)
#pragma unroll
                for (int bj = 0; bj < 2; ++bj) f(row0 + ai * 128 + m * 16, col0 + bj * 128, acc[ai][bj][m][0], acc[ai][bj][m][1]);
    } };

template <class Fn>
__device__ __forceinline__ void tail_gemm(const Frame& F, const bf16* A, const bf16* Bt, const int K, const int N, const Fn& f) {
    const int lane = F.lane, wave = F.wave, fr = lane & 15, fq = lane >> 4;
    const int nunits = (MTAIL / 32) * (N / 64), kw = K / 8;
    LAS f32x4* red = (LAS f32x4*)F.lds;
    for (int u = F.wg; u < nunits; u += F.nwg) {
        const int nb = u / (MTAIL / 32), mb = u % (MTAIL / 32), rb = MMAIN + 32 * mb, cb = 64 * nb;
        f32x4 acc[2][2][2];
#pragma unroll
        for (int i = 0; i < 8; ++i) acc[i >> 2][(i >> 1) & 1][i & 1] = (f32x4){0.f, 0.f, 0.f, 0.f};
        const bf16* ap = A + (size_t)(rb + fr) * K + wave * kw + 8 * fq;
        const bf16* bp = Bt + (size_t)(cb + 8 * (fr >> 2) + (fr & 3)) * K + wave * kw + 8 * fq;
#pragma unroll 4
        for (int ks = 0; ks < kw / 32; ++ks) {
            bf16x8 a[2], b[2][2];
#pragma unroll
            for (int mi = 0; mi < 2; ++mi) a[mi] = *(const bf16x8*)(ap + (size_t)mi * 16 * K + ks * 32);
#pragma unroll
            for (int g = 0; g < 2; ++g)
#pragma unroll
                for (int n = 0; n < 2; ++n) b[g][n] = *(const bf16x8*)(bp + (size_t)(32 * g + 4 * n) * K + ks * 32);
#pragma unroll
            for (int mi = 0; mi < 2; ++mi)
#pragma unroll
                for (int g = 0; g < 2; ++g)
#pragma unroll
                    for (int n = 0; n < 2; ++n) acc[mi][g][n] = __builtin_amdgcn_mfma_f32_16x16x32_bf16(b[g][n], a[mi], acc[mi][g][n], 0, 0, 0);
        }
#pragma unroll
        for (int i = 0; i < 8; ++i) red[(wave * 8 + i) * 64 + lane] = acc[i >> 2][(i >> 1) & 1][i & 1];
        __syncthreads();
        if (wave < 4) {
            const int mi = wave >> 1, g = wave & 1;
            f32x4 v0 = (f32x4){0.f, 0.f, 0.f, 0.f}, v1 = v0;
#pragma unroll
            for (int w = 0; w < 8; ++w) { v0 += red[(w * 8 + (mi * 2 + g) * 2 + 0) * 64 + lane]; v1 += red[(w * 8 + (mi * 2 + g) * 2 + 1) * 64 + lane]; }
            f(rb + 16 * mi + fr, cb + 32 * g + 8 * fq, v0, v1);
        }
        __syncthreads();
    }
}
template <bool PERMIN>
__device__ __forceinline__ void p0_transpose_item(const float* W, int K, int N, bf16* WT, LAS float* scr, int item, int lane) {
    const int nblk = N / 32, kb = item / nblk, nb = item % nblk, k0 = 64 * kb, n0 = 32 * nb;
    const int nsrc = PERMIN ? win_src_col(n0 + (lane & 31)) : n0 + (lane & 31);
#pragma unroll 8
    for (int i = 0; i < 32; ++i) { const int kk = 2 * i + (lane >> 5); scr[kk * 33 + (lane & 31)] = W[(size_t)(k0 + kk) * N + nsrc]; }
    asm volatile("s_waitcnt lgkmcnt(0)" ::: "memory");
    const int c = lane & 7;
#pragma unroll
    for (int j = 0; j < 4; ++j) { const int n = (lane >> 3) + 8 * j; const LAS float* s = scr + (8 * c) * 33 + n;
        v4u o; o.x = pk2(s[0 * 33], s[1 * 33]); o.y = pk2(s[2 * 33], s[3 * 33]); o.z = pk2(s[4 * 33], s[5 * 33]); o.w = pk2(s[6 * 33], s[7 * 33]);
        *(v4u*)(WT + (size_t)(n0 + n) * K + k0 + 8 * c) = o; }
    asm volatile("s_waitcnt lgkmcnt(0)" ::: "memory");
}
__device__ __forceinline__ void rms_row_to_bf16(const float* xr_, const float* g, bf16* orow, int lane) {
    const f32x4* xr = (const f32x4*)xr_ + lane; const f32x4* gr = (const f32x4*)g + lane;
    f32x4 v[4]; float s = 0.f;
#pragma unroll
    for (int j = 0; j < 4; ++j) { v[j] = xr[64 * j]; s += (v[j].x * v[j].x + v[j].y * v[j].y) + (v[j].z * v[j].z + v[j].w * v[j].w); }
    const float rs = 1.0f / sqrtf(wave_sum(s) * (1.f / D) + EPS);
    unsigned long long* o8 = (unsigned long long*)orow + lane;
#pragma unroll
    for (int j = 0; j < 4; ++j) { const f32x4 gg = gr[64 * j];
        o8[64 * j] = (unsigned long long)pk2(v[j].x * rs * gg.x, v[j].y * rs * gg.y) | ((unsigned long long)pk2(v[j].z * rs * gg.z, v[j].w * rs * gg.w) << 32); }
}
__device__ __forceinline__ void p0_prologue(const Frame& F) {
    LAS float* scr = (LAS float*)(F.lds + F.wave * 16384);
    const int gw = F.wg * NWAVES + F.wave, NGW = F.nwg * NWAVES;
    constexpr int I_IN = (D / 64) * (NIN / 32), I_O = (D / 64) * (D / 32), I_1 = (D / 64) * (FF / 32), I_2 = (FF / 64) * (D / 32);
    constexpr int NITEMS = I_IN + I_O + I_1 + I_2;
    for (int it = gw; it < NITEMS; it += NGW) {
        int r = it;
        if (r < I_IN) { p0_transpose_item<true>(F.w_in, D, NIN, F.Win_t, scr, r, F.lane); continue; } r -= I_IN;
        if (r < I_O) { p0_transpose_item<false>(F.w_out, D, D, F.Wout_t, scr, r, F.lane); continue; } r -= I_O;
        if (r < I_1) { p0_transpose_item<false>(F.w_mi, D, FF, F.Wmi_t, scr, r, F.lane); continue; } r -= I_1;
        p0_transpose_item<false>(F.w_mo, FF, D, F.Wmo_t, scr, r, F.lane);
    }
    for (int m = gw; m < R; m += NGW) {
        if (m < NREAL) rms_row_to_bf16(xrow(F, m), F.g_pre_mix, F.BufA + (size_t)m * D, F.lane);
        else { unsigned long long* o8 = (unsigned long long*)(F.BufA + (size_t)m * D) + F.lane;
#pragma unroll
            for (int j = 0; j < 4; ++j) o8[64 * j] = 0ull; }
    }
}

__device__ __forceinline__ void chunk_geom(int cid, int& row0, int& off) {
    if (cid == 0) { row0 = ROW_META - 48; off = 48; }
    else if (cid <= 256) { row0 = (cid - 1) * 64; off = 0; }
    else { row0 = ROW_SMP + (cid - 257) * 16 - 48; off = 48; }
}

constexpr int TS = 130;
__device__ __forceinline__ bf16x8 gather_col(const LAS bf16* T, int r0, int c) {
    bf16x8 v;
#pragma unroll
    for (int t = 0; t < 8; ++t) v[t] = (short)T[(r0 + t) * TS + c];
    return v;
}
__device__ __forceinline__ void lds_put16(LAS bf16* T, int r, int c8, v4u w) {
    LAS unsigned* p = (LAS unsigned*)(T + r * TS + c8);
    p[0] = w.x; p[1] = w.y; p[2] = w.z; p[3] = w.w;
}
__device__ __forceinline__ void kv_unit(const Frame& F, int cid, int h) {
    LAS bf16* Ks = (LAS bf16*)F.lds; LAS bf16* Vs = Ks + 64 * TS;
    int row0, off; chunk_geom(cid, row0, off);
    const float lg = lg2gamma(h);
    __syncthreads();
#pragma unroll
    for (int i = 0; i < 2; ++i) {
        const int p = F.tid + NT * i, j = p >> 4, seg = p & 15;
        v4u kw = (v4u){0u, 0u, 0u, 0u}, vw = kw;
        if (j >= off) {
            kw = *(const v4u*)(F.Kb + (size_t)(row0 + j) * 512 + h * 128 + seg * 8);
            vw = *(const v4u*)(F.Vb + (size_t)(row0 + j) * 512 + h * 128 + seg * 8);
            const float w = ex2(lg * (float)(63 - j));
            kw.x = pk2(bflo(kw.x) * w, bfhi(kw.x) * w); kw.y = pk2(bflo(kw.y) * w, bfhi(kw.y) * w); kw.z = pk2(bflo(kw.z) * w, bfhi(kw.z) * w); kw.w = pk2(bflo(kw.w) * w, bfhi(kw.w) * w);
        }
        lds_put16(Ks, j, seg * 8, kw); lds_put16(Vs, j, seg * 8, vw);
    }
    __syncthreads();
    const int fr = F.lane & 15, fq = F.lane >> 4, e0 = 16 * F.wave;
    f32x4 acc[8];
#pragma unroll
    for (int db = 0; db < 8; ++db) acc[db] = (f32x4){0.f, 0.f, 0.f, 0.f};
#pragma unroll
    for (int ks = 0; ks < 2; ++ks) {
        const bf16x8 vf = gather_col(Vs, 32 * ks + 8 * fq, e0 + fr);
#pragma unroll
        for (int db = 0; db < 8; ++db) { const bf16x8 kf = gather_col(Ks, 32 * ks + 8 * fq, 16 * db + fr);
            acc[db] = __builtin_amdgcn_mfma_f32_16x16x32_bf16(kf, vf, acc[db], 0, 0, 0); asm volatile("" ::: "memory"); }
    }
    if (cid <= 256) {
        float* o = F.KVt + ((size_t)(cid * 4 + h) * 128 + e0 + fr) * 128 + 4 * fq;
#pragma unroll
        for (int db = 0; db < 8; ++db) *(f32x4*)(o + 16 * db) = acc[db];
    } else {
        const int b = cid - 257; const float g16 = ex2(lg * 16.0f);
        const size_t base = (size_t)(b * 4 + h) * 16384;
#pragma unroll
        for (int db = 0; db < 8; ++db)
#pragma unroll
            for (int r = 0; r < 4; ++r) { const size_t idx = base + (size_t)dorig(16 * db + 4 * fq + r) * 128 + e0 + fr;
                F.out[O_SS + idx] = g16 * F.state[idx] + acc[db][r]; }
#pragma unroll
        for (int i = 0; i < 4; ++i) {
            const int p = F.tid + NT * i, seg = p >> 7, e = p & 127;
            float s[8];
#pragma unroll
            for (int t = 0; t < 8; ++t) s[t] = F.state[base + (size_t)dorig(8 * seg + t) * 128 + e];
            v4u w; w.x = pk2(s[0], s[1]); w.y = pk2(s[2], s[3]); w.z = pk2(s[4], s[5]); w.w = pk2(s[6], s[7]);
            *(v4u*)(F.St + ((size_t)(cid * 4 + h) * 128 + e) * 128 + 8 * seg) = w;
        }
    }
}

template <int RPW>
__device__ __forceinline__ void conv_compute(const Frame& F, const LAS bf16* us, const LAS bf16* wts, int rowbase) {
    const int c0 = F.lane * 8, r0 = F.wave * RPW;
    float acc[RPW][8];
    { const f32x4 b0 = *(const f32x4*)(F.dw_b + c0), b1 = *(const f32x4*)(F.dw_b + c0 + 4);
#pragma unroll
      for (int o = 0; o < RPW; ++o) { acc[o][0] = b0.x; acc[o][1] = b0.y; acc[o][2] = b0.z; acc[o][3] = b0.w; acc[o][4] = b1.x; acc[o][5] = b1.y; acc[o][6] = b1.z; acc[o][7] = b1.w; } }
#pragma unroll 1
    for (int tap = 0; tap < CK; ++tap) {
        const v4u ww = *(const LAS v4u*)(wts + tap * 512 + c0);
        const float w[8] = {bflo(ww.x), bfhi(ww.x), bflo(ww.y), bfhi(ww.y), bflo(ww.z), bfhi(ww.z), bflo(ww.w), bfhi(ww.w)};
#pragma unroll
        for (int o = 0; o < RPW; ++o) {
            const v4u uu = *(const LAS v4u*)(us + (r0 + o + tap) * 512 + c0);
            acc[o][0] += w[0] * bflo(uu.x); acc[o][1] += w[1] * bfhi(uu.x); acc[o][2] += w[2] * bflo(uu.y); acc[o][3] += w[3] * bfhi(uu.y);
            acc[o][4] += w[4] * bflo(uu.z); acc[o][5] += w[5] * bfhi(uu.z); acc[o][6] += w[6] * bflo(uu.w); acc[o][7] += w[7] * bfhi(uu.w);
        }
    }
    const f32x4 g0 = *(const f32x4*)(F.cln_g + c0), g1 = *(const f32x4*)(F.cln_g + c0 + 4), b0 = *(const f32x4*)(F.cln_b + c0), b1 = *(const f32x4*)(F.cln_b + c0 + 4);
    const float g[8] = {g0.x, g0.y, g0.z, g0.w, g1.x, g1.y, g1.z, g1.w}, bb[8] = {b0.x, b0.y, b0.z, b0.w, b1.x, b1.y, b1.z, b1.w};
#pragma unroll
    for (int o = 0; o < RPW; ++o) {
        float s = 0.f;
#pragma unroll
        for (int t = 0; t < 8; ++t) s += acc[o][t];
        const float mu = wave_sum(s) * (1.f / CW);
        float q = 0.f;
#pragma unroll
        for (int t = 0; t < 8; ++t) { const float dlt = acc[o][t] - mu; q += dlt * dlt; }
        const float rs = 1.0f / sqrtf(wave_sum(q) * (1.f / CW) + EPS);
        float y[8];
#pragma unroll
        for (int t = 0; t < 8; ++t) y[t] = siluf_((acc[o][t] - mu) * rs * g[t] + bb[t]);
        v4u w; w.x = pk2(y[0], y[1]); w.y = pk2(y[2], y[3]); w.z = pk2(y[4], y[5]); w.w = pk2(y[6], y[7]);
        *(v4u*)(F.BufA + (size_t)(rowbase + r0 + o) * D + 512 + c0) = w;
    }
}
__device__ __forceinline__ void conv_unit(const Frame& F, int cid) {
    LAS bf16* us = (LAS bf16*)F.lds;
    LAS bf16* wts = us + 94 * 512;
    const int L = (cid >= 1 && cid <= 256) ? 64 : 16;
    const int rowbase = cid == 0 ? ROW_META : (cid <= 256 ? (cid - 1) * 64 : ROW_SMP + (cid - 257) * 16);
    __syncthreads();
    for (int p = F.tid; p < (30 + L) * 64; p += NT) {
        const int x = p >> 6, seg = p & 63;
        v4u w = (v4u){0u, 0u, 0u, 0u};
        if (x >= 30) w = *(const v4u*)(F.Ub + (size_t)(rowbase + x - 30) * 512 + seg * 8);
        else if (cid > 256) { const float* s = F.cache + ((size_t)(cid - 257) * 30 + x) * 512 + seg * 8; const f32x4 a = *(const f32x4*)s, b = *(const f32x4*)(s + 4);
            w.x = pk2(a.x, a.y); w.y = pk2(a.z, a.w); w.z = pk2(b.x, b.y); w.w = pk2(b.z, b.w); }
        else if (cid >= 1) { const int pos = 16 + (cid - 1) * 64 - 30 + x;
            if (pos >= 0) { const int row = pos < 16 ? ROW_META + pos : pos - 16; w = *(const v4u*)(F.Ub + (size_t)row * 512 + seg * 8); } }
        *(LAS v4u*)(us + x * 512 + seg * 8) = w;
    }
    for (int p = F.tid; p < CK * 64; p += NT) { const float* s = F.dw_w + (size_t)p * 8; const f32x4 a = *(const f32x4*)s, b = *(const f32x4*)(s + 4);
        v4u w; w.x = pk2(a.x, a.y); w.y = pk2(a.z, a.w); w.z = pk2(b.x, b.y); w.w = pk2(b.z, b.w); *(LAS v4u*)(wts + p * 8) = w; }
    __syncthreads();
    if (L == 64) conv_compute<8>(F, us, wts, rowbase); else conv_compute<2>(F, us, wts, rowbase);
    if (cid == 256) {
        for (int i = F.tid; i < 30 * 512; i += NT) F.out[O_CP + i] = bf1(us[64 * 512 + i]);
    } else if (cid > 256) {
        const int b = cid - 257;
        for (int i = F.tid; i < 30 * 512; i += NT) { const int r = i >> 9;
            F.out[O_CS + (size_t)b * 30 * 512 + i] = r < 14 ? F.cache[((size_t)b * 30 + 16) * 512 + i] : bf1(us[16 * 512 + i]); }
    }
}

__device__ __forceinline__ void scan_phase(const Frame& F) {
    if (F.tid >= 256) return;
    for (int el = F.wg * 256 + F.tid; el < 65536; el += F.nwg * 256) {
        const int h = el >> 14, within = el & 16383, e = within >> 7, dp = within & 127;
        const float a = ex2(lg2gamma(h) * 64.0f);
        float s = 0.f;
        const float* kv = F.KVt + (size_t)h * 16384 + within; bf16* st = F.St + (size_t)h * 16384 + within;
#pragma unroll 8
        for (int c = 0; c < 257; ++c) { st[(size_t)c * 65536] = (bf16)f2bf(s); s = a * s + kv[(size_t)c * 65536]; }
        F.out[O_SP + (size_t)(h * 128 + dorig(dp)) * 128 + e] = s;
    }
}

constexpr int PS = 72;
__device__ __forceinline__ void ret_unit(const Frame& F, int cid, int hp) {
    LAS bf16* Vs = (LAS bf16*)F.lds;
    LAS bf16* Pw = (LAS bf16*)(F.lds + 2 * 64 * TS * 2) + F.wave * 16 * PS;
    int row0, off; chunk_geom(cid, row0, off);
    __syncthreads();
#pragma unroll
    for (int i = 0; i < 4; ++i) {
        const int p = F.tid + NT * i, hh = p >> 10, j = (p >> 4) & 63, seg = p & 15;
        v4u vw = (v4u){0u, 0u, 0u, 0u};
        if (j >= off) vw = *(const v4u*)(F.Vb + (size_t)(row0 + j) * 512 + (2 * hp + hh) * 128 + seg * 8);
        lds_put16(Vs + hh * 64 * TS, j, seg * 8, vw);
    }
    __syncthreads();
    const int fr = F.lane & 15, fq = F.lane >> 4, hh = F.wave >> 2, ib = F.wave & 3, h = 2 * hp + hh;
    const int i_loc = 16 * ib + fr;
    const bool ivalid = i_loc >= off;
    const float lg = lg2gamma(h);
    bf16x8 qf[4];
#pragma unroll
    for (int ks = 0; ks < 4; ++ks) { qf[ks] = (bf16x8){0, 0, 0, 0, 0, 0, 0, 0};
        if (ivalid) qf[ks] = *(const bf16x8*)(F.Qb + (size_t)(row0 + i_loc) * 512 + h * 128 + 32 * ks + 8 * fq); }
    f32x4 sc[4];
#pragma unroll
    for (int jb = 0; jb < 4; ++jb) { sc[jb] = (f32x4){0.f, 0.f, 0.f, 0.f};
        const int j = 16 * jb + fr;
#pragma unroll
        for (int ks = 0; ks < 4; ++ks) { bf16x8 kf = (bf16x8){0, 0, 0, 0, 0, 0, 0, 0};
            if (j >= off) kf = *(const bf16x8*)(F.Kb + (size_t)(row0 + j) * 512 + h * 128 + 32 * ks + 8 * fq);
            sc[jb] = __builtin_amdgcn_mfma_f32_16x16x32_bf16(kf, qf[ks], sc[jb], 0, 0, 0); } }
#pragma unroll
    for (int jb = 0; jb < 4; ++jb) { float pv[4];
#pragma unroll
        for (int r = 0; r < 4; ++r) { const int j = 16 * jb + 4 * fq + r; const int dd = i_loc > j ? i_loc - j : j - i_loc; pv[r] = sc[jb][r] * ex2(lg * (float)dd); }
        v2u w; w.x = pk2(pv[0], pv[1]); w.y = pk2(pv[2], pv[3]);
        *(LAS v2u*)(Pw + fr * PS + 16 * jb + 4 * fq) = w; }
    asm volatile("s_waitcnt lgkmcnt(0)" ::: "memory");
    f32x4 ao[8], ai[8];
#pragma unroll
    for (int eb = 0; eb < 8; ++eb) { ao[eb] = (f32x4){0.f, 0.f, 0.f, 0.f}; ai[eb] = ao[eb]; }
#pragma unroll
    for (int ks = 0; ks < 2; ++ks) {
        const bf16x8 pf = *(const LAS bf16x8*)(Pw + fr * PS + 32 * ks + 8 * fq);
#pragma unroll
        for (int eb = 0; eb < 8; ++eb) { const bf16x8 vf = gather_col(Vs + hh * 64 * TS, 32 * ks + 8 * fq, 16 * eb + fr);
            ao[eb] = __builtin_amdgcn_mfma_f32_16x16x32_bf16(vf, pf, ao[eb], 0, 0, 0); }
    }
    const bf16* st = F.St + ((size_t)(cid * 4 + h) * 128 + fr) * 128 + 8 * fq;
#pragma unroll
    for (int eb = 0; eb < 8; ++eb)
#pragma unroll
        for (int ks = 0; ks < 4; ++ks) { const bf16x8 sf = *(const bf16x8*)(st + (size_t)(16 * eb) * 128 + 32 * ks);
            ai[eb] = __builtin_amdgcn_mfma_f32_16x16x32_bf16(sf, qf[ks], ai[eb], 0, 0, 0); }
    const float din = ex2(lg * (float)(i_loc - off + 1));
    float s = 0.f;
#pragma unroll
    for (int eb = 0; eb < 8; ++eb) { ao[eb] = ao[eb] + ai[eb] * din; s += (ao[eb][0] + ao[eb][1]) + (ao[eb][2] + ao[eb][3]); }
    s += __shfl_xor(s, 16); s += __shfl_xor(s, 32);
    const float mu = s * (1.f / HD);
    float q = 0.f;
#pragma unroll
    for (int eb = 0; eb < 8; ++eb) { const f32x4 dlt = ao[eb] - mu; q += (dlt[0] * dlt[0] + dlt[1] * dlt[1]) + (dlt[2] * dlt[2] + dlt[3] * dlt[3]); }
    q += __shfl_xor(q, 16); q += __shfl_xor(q, 32);
    const float rs = 1.0f / sqrtf(q * (1.f / HD) + EPS);
    if (ivalid) {
        const int row = row0 + i_loc;
#pragma unroll
        for (int eb = 0; eb < 8; ++eb) { const int c = h * 128 + 16 * eb + 4 * fq;
            const f32x4 gg = *(const f32x4*)(F.gn_g + c), gb = *(const f32x4*)(F.gn_b + c);
            const v2u sg = *(const v2u*)(F.Gb + (size_t)row * 512 + c);
            const f32x4 rn = (ao[eb] - mu) * rs * gg + gb;
            v2u w; w.x = pk2(rn[0] * bflo(sg.x), rn[1] * bfhi(sg.x)); w.y = pk2(rn[2] * bflo(sg.y), rn[3] * bfhi(sg.y));
            *(v2u*)(F.BufA + (size_t)row * D + c) = w; }
    }
}

__device__ __forceinline__ void rowpass1(const Frame& F) {
    const int gw = F.wg * NWAVES + F.wave, NGW = F.nwg * NWAVES;
    for (int row = gw; row < NREAL; row += NGW) {
        const float* xr = xrow(F, row);
        float m[16], x[16]; float ss = 0.f;
#pragma unroll
        for (int i = 0; i < 2; ++i) { const int c = 512 * i + 8 * F.lane;
            const v4u w = *(const v4u*)(F.BufB + (size_t)row * D + c);
            m[8 * i + 0] = bflo(w.x); m[8 * i + 1] = bfhi(w.x); m[8 * i + 2] = bflo(w.y); m[8 * i + 3] = bfhi(w.y); m[8 * i + 4] = bflo(w.z); m[8 * i + 5] = bfhi(w.z); m[8 * i + 6] = bflo(w.w); m[8 * i + 7] = bfhi(w.w);
            const f32x4 a = *(const f32x4*)(xr + c), b = *(const f32x4*)(xr + c + 4);
            x[8 * i + 0] = a.x; x[8 * i + 1] = a.y; x[8 * i + 2] = a.z; x[8 * i + 3] = a.w; x[8 * i + 4] = b.x; x[8 * i + 5] = b.y; x[8 * i + 6] = b.z; x[8 * i + 7] = b.w; }
#pragma unroll
        for (int t = 0; t < 16; ++t) ss += m[t] * m[t];
        const float rs1 = 1.0f / sqrtf(wave_sum(ss) * (1.f / D) + EPS);
        float s2 = 0.f;
#pragma unroll
        for (int i = 0; i < 2; ++i) { const int c = 512 * i + 8 * F.lane; const f32x4 ga = *(const f32x4*)(F.g_post_mix + c), gb = *(const f32x4*)(F.g_post_mix + c + 4);
            const float g[8] = {ga.x, ga.y, ga.z, ga.w, gb.x, gb.y, gb.z, gb.w};
#pragma unroll
            for (int t = 0; t < 8; ++t) { x[8 * i + t] += m[8 * i + t] * rs1 * g[t]; s2 += x[8 * i + t] * x[8 * i + t]; } }
        const float rs2 = 1.0f / sqrtf(wave_sum(s2) * (1.f / D) + EPS);
        float* xo = row < ROW_META ? F.out + O_YP + (size_t)row * D : (row >= ROW_SMP ? F.out + O_YS + (size_t)(row - ROW_SMP) * D : nullptr);
#pragma unroll
        for (int i = 0; i < 2; ++i) { const int c = 512 * i + 8 * F.lane; const f32x4 ga = *(const f32x4*)(F.g_pre_mlp + c), gb = *(const f32x4*)(F.g_pre_mlp + c + 4);
            const float g[8] = {ga.x, ga.y, ga.z, ga.w, gb.x, gb.y, gb.z, gb.w};
            if (xo) { *(f32x4*)(xo + c) = (f32x4){x[8 * i], x[8 * i + 1], x[8 * i + 2], x[8 * i + 3]}; *(f32x4*)(xo + c + 4) = (f32x4){x[8 * i + 4], x[8 * i + 5], x[8 * i + 6], x[8 * i + 7]}; }
            v4u w; w.x = pk2(x[8 * i] * rs2 * g[0], x[8 * i + 1] * rs2 * g[1]); w.y = pk2(x[8 * i + 2] * rs2 * g[2], x[8 * i + 3] * rs2 * g[3]);
            w.z = pk2(x[8 * i + 4] * rs2 * g[4], x[8 * i + 5] * rs2 * g[5]); w.w = pk2(x[8 * i + 6] * rs2 * g[6], x[8 * i + 7] * rs2 * g[7]);
            *(v4u*)(F.BufA + (size_t)row * D + c) = w; }
    }
}
__device__ __forceinline__ void rowpass2(const Frame& F) {
    const int gw = F.wg * NWAVES + F.wave, NGW = F.nwg * NWAVES;
    for (int row = gw; row < NREAL; row += NGW) {
        if (row >= ROW_META && row < ROW_SMP) continue;
        float* xo = row < ROW_META ? F.out + O_YP + (size_t)row * D : F.out + O_YS + (size_t)(row - ROW_SMP) * D;
        float m[16]; float ss = 0.f;
#pragma unroll
        for (int i = 0; i < 2; ++i) { const int c = 512 * i + 8 * F.lane;
            const v4u w = *(const v4u*)(F.BufA + (size_t)row * D + c);
            m[8 * i + 0] = bflo(w.x); m[8 * i + 1] = bfhi(w.x); m[8 * i + 2] = bflo(w.y); m[8 * i + 3] = bfhi(w.y); m[8 * i + 4] = bflo(w.z); m[8 * i + 5] = bfhi(w.z); m[8 * i + 6] = bflo(w.w); m[8 * i + 7] = bfhi(w.w); }
#pragma unroll
        for (int t = 0; t < 16; ++t) ss += m[t] * m[t];
        const float rs = 1.0f / sqrtf(wave_sum(ss) * (1.f / D) + EPS);
#pragma unroll
        for (int i = 0; i < 2; ++i) { const int c = 512 * i + 8 * F.lane; const f32x4 ga = *(const f32x4*)(F.g_post_mlp + c), gb = *(const f32x4*)(F.g_post_mlp + c + 4);
            f32x4 a = *(const f32x4*)(xo + c), b = *(const f32x4*)(xo + c + 4);
            a.x += m[8 * i] * rs * ga.x; a.y += m[8 * i + 1] * rs * ga.y; a.z += m[8 * i + 2] * rs * ga.z; a.w += m[8 * i + 3] * rs * ga.w;
            b.x += m[8 * i + 4] * rs * gb.x; b.y += m[8 * i + 5] * rs * gb.y; b.z += m[8 * i + 6] * rs * gb.z; b.w += m[8 * i + 7] * rs * gb.w;
            *(f32x4*)(xo + c) = a; *(f32x4*)(xo + c + 4) = b; }
    }
}

struct Args { const float* in[19]; float* out; unsigned char* ws; int ph_lo, ph_hi; };
template <class Fn> __device__ __forceinline__ void gemm_both(const Frame& F, const bf16* A, const bf16* Bt, int N, int K, const Fn& fn) {
    pg8::Gemm g{A, Bt, MMAIN, N, K}; pg8::StaticOrder S; S.init(MMAIN, N, F.nwg, F.wg);
    EpiAd<Fn> E{fn};
    pg8::gemm_phase<EpiAd<Fn>, pg8::StaticOrder, true, true>(F.lds, g, S, E);
    __syncthreads();
    tail_gemm(F, A, Bt, K, N, fn);
}
__global__ void __launch_bounds__(NT, 2) hymba_fwd(Args args) {
    extern __shared__ __attribute__((aligned(16))) unsigned char lds_raw[];
    cg::grid_group grid = cg::this_grid();
    Frame F;
    F.lds = (LAS unsigned char*)lds_raw;
    F.tid = threadIdx.x; F.lane = F.tid & 63; F.wave = __builtin_amdgcn_readfirstlane(F.tid >> 6); F.wg = blockIdx.x; F.nwg = gridDim.x;
    F.xp = args.in[0]; F.xs = args.in[1]; F.state = args.in[2]; F.cache = args.in[3]; F.meta = args.in[4]; F.g_pre_mix = args.in[5]; F.w_in = args.in[6];
    F.gn_g = args.in[7]; F.gn_b = args.in[8]; F.dw_w = args.in[9]; F.dw_b = args.in[10]; F.cln_g = args.in[11]; F.cln_b = args.in[12]; F.w_out = args.in[13];
    F.g_post_mix = args.in[14]; F.g_pre_mlp = args.in[15]; F.w_mi = args.in[16]; F.w_mo = args.in[17]; F.g_post_mlp = args.in[18];
    F.out = args.out;
    unsigned char* ws = args.ws;
    F.Win_t = (bf16*)(ws + WS_WIN); F.Wout_t = (bf16*)(ws + WS_WOUT); F.Wmi_t = (bf16*)(ws + WS_WMI); F.Wmo_t = (bf16*)(ws + WS_WMO);
    F.BufA = (bf16*)(ws + WS_BUFA); F.BufB = (bf16*)(ws + WS_BUFB); F.Ub = F.BufB; F.Gb = F.BufB + (size_t)R * 512;
    F.Qb = (bf16*)(ws + WS_Q); F.Kb = (bf16*)(ws + WS_K); F.Vb = (bf16*)(ws + WS_V); F.KVt = (float*)(ws + WS_KVT); F.St = (bf16*)(ws + WS_ST); F.HID = (bf16*)(ws + WS_HID);
    const int lo = args.ph_lo, hi = args.ph_hi;
#ifndef PH_MASK
#define PH_MASK 0x3ff
#endif
#define IN(k) (((PH_MASK >> (k)) & 1) && lo <= (k) && (k) < hi)
#define SEAM(k) do { if (IN(k) && IN((k) + 1)) grid.sync(); } while (0)
    if (IN(0)) p0_prologue(F);
    SEAM(0);
    if (IN(1)) gemm_both(F, F.BufA, F.Win_t, NIN, D, FProj{F.Qb, F.Kb, F.Vb, F.Gb, F.Ub});
    SEAM(1);
    if (IN(2)) {
        for (int u = F.wg; u < NCH; u += F.nwg) conv_unit(F, u);
        asm volatile("" ::: "memory");
        for (int u = (F.wg + ((NCH + F.nwg - 1) / F.nwg) * F.nwg - NCH) % F.nwg; u < NCH * 4; u += F.nwg) kv_unit(F, u >> 2, u & 3);
        __syncthreads();
    }
    SEAM(2);
    if (IN(3)) scan_phase(F);
    SEAM(3);
    if (IN(4)) { for (int u = F.wg; u < NCH * 2; u += F.nwg) ret_unit(F, u >> 1, u & 1); __syncthreads(); }
    SEAM(4);
    if (IN(5)) gemm_both(F, F.BufA, F.Wout_t, D, D, FStore{F.BufB, D});
    SEAM(5);
    if (IN(6)) rowpass1(F);
    SEAM(6);
    if (IN(7)) gemm_both(F, F.BufA, F.Wmi_t, FF, D, FRelu2{F.HID, FF});
    SEAM(7);
    if (IN(8)) gemm_both(F, F.HID, F.Wmo_t, D, FF, FStore{F.BufA, D});
    SEAM(8);
    if (IN(9)) rowpass2(F);
#undef IN
#undef SEAM
}

#ifndef N_LAUNCH_PER_PHASE
#define N_LAUNCH_PER_PHASE 0
#endif
extern "C" void kernel_launch(void* const* d_in, const int* in_sizes, int n_in, void* d_out, int out_size, void* d_ws, size_t ws_size, hipStream_t stream) {
    static int grid = 0;
    if (grid == 0) {
        if (n_in != 19 || ws_size < WS_END) { fprintf(stderr, "kernel_launch: unexpected problem (n_in %d, ws %zu)\n", n_in, ws_size); grid = -1; return; }
        int dev = 0, cus = 0, per_cu = 0;
        hipGetDevice(&dev); hipDeviceGetAttribute(&cus, hipDeviceAttributeMultiprocessorCount, dev);
        if (hipFuncSetAttribute((const void*)hymba_fwd, hipFuncAttributeMaxDynamicSharedMemorySize, LDS_BYTES) != hipSuccess) { fprintf(stderr, "kernel_launch: hipFuncSetAttribute failed\n"); grid = -1; return; }
        if (hipOccupancyMaxActiveBlocksPerMultiprocessor(&per_cu, (const void*)hymba_fwd, NT, LDS_BYTES) != hipSuccess || per_cu < 1) { fprintf(stderr, "kernel_launch: occupancy query failed (%d)\n", per_cu); (void)hipGetLastError(); per_cu = 1; }
        grid = cus * per_cu;
        fprintf(stderr, "kernel_launch: %d CUs x %d = grid %d\n", cus, per_cu, grid);
    }
    if (grid < 0) return;
    Args a{};
    for (int i = 0; i < 19; ++i) a.in[i] = (const float*)d_in[i];
    a.out = (float*)d_out; a.ws = (unsigned char*)d_ws;
#if N_LAUNCH_PER_PHASE
    for (int p = 0; p < 10; ++p) { a.ph_lo = p; a.ph_hi = p + 1; hipLaunchKernelGGL(hymba_fwd, dim3(grid), dim3(NT), LDS_BYTES, stream, a); }
#else
    a.ph_lo = 0; a.ph_hi = 10;
    void* kargs[] = {&a};
    hipError_t e = hipLaunchCooperativeKernel((const void*)hymba_fwd, dim3(grid), dim3(NT), kargs, LDS_BYTES, stream);
    if (e != hipSuccess) fprintf(stderr, "kernel_launch: cooperative launch failed: %s (grid %d)\n", hipGetErrorString(e), grid);
#endif
}
```

```cpp
#include <hip/hip_runtime.h>
#include <hip/hip_cooperative_groups.h>
#include <cstdio>
#include <cstdint>
namespace cg = cooperative_groups;
namespace pg8 {
#define PG8_LAS __attribute__((address_space(3)))
typedef unsigned short bf16_t;
typedef short bf16x8 __attribute__((ext_vector_type(8)));
typedef float f32x4 __attribute__((ext_vector_type(4)));
typedef unsigned u32x4 __attribute__((ext_vector_type(4)));
constexpr int BM = 256, BK = 64, HALF = 128, HTB = HALF * BK * 2  , STAGE_BYTES = 8 * HTB, NXCD = 8, WGM = 8;

__host__ __device__ __forceinline__ int lds_byte(int r, int c) { const int st = (r >> 4) * 2 + (c >> 5), rr = r & 15, cc = c & 31, ob = rr * 64 + cc * 2; return st * 1024 + (ob ^ (((ob >> 9) & 1) << 5)); }
__host__ __device__ __forceinline__ void stage_rc(int b, int& R, int& C) { const int st = b / 1024, sb = b % 1024, swz = sb ^ (((sb >> 9) & 1) << 5); R = (st >> 1) * 16 + swz / 64; C = (st & 1) * 32 + (swz % 64) / 2; }
__host__ __device__ __forceinline__ int perm32(int rho) { const int n = rho >> 4, i = rho & 15; return 8 * (i >> 2) + 4 * n + (i & 3); }

struct Unit { int pm, pn; };
struct Gemm { const bf16_t* A; const bf16_t* Bt; int M, N, K; };

struct StaticOrder {
    int nM, nN, nwg, G, c;
    __host__ __device__ void init(int M, int N, int G_, int c_) { nM = M / BM; nN = N / BM; nwg = nM * nN; G = G_; c = c_; }
    __host__ __device__ bool next(int i, Unit& u) const {
        const long L = (long)i * G + c; if (L >= nwg) return false;
        int wgid = (int)L; { const int q = nwg / NXCD, r = nwg % NXCD, xcd = wgid % NXCD, off = wgid / NXCD; wgid = (xcd < r ? xcd * (q + 1) : r * (q + 1) + (xcd - r) * q) + off; }
        const int nig = WGM * nN, gid = wgid / nig, fm = gid * WGM, gsz = (nM - fm) < WGM ? (nM - fm) : WGM;
        u.pm = fm + ((wgid % nig) % gsz); u.pn = (wgid % nig) / gsz; return true;
    }
    __device__ __forceinline__ void a_ready(const Unit&) const {}
    __device__ __forceinline__ void done(const Unit&) const {}
};

__device__ __forceinline__ unsigned cvt_pk_bf16(float lo, float hi) { unsigned r; asm volatile("v_cvt_pk_bf16_f32 %0, %1, %2" : "=v"(r) : "v"(lo), "v"(hi)); return r; }
template <class Epi, class Sched, bool ALIGN_EPI = false, bool SP2 = false>
__device__ __forceinline__ void gemm_phase(PG8_LAS unsigned char* lds, const Gemm g, const Sched& S, const Epi& E) {
    const int tid = threadIdx.x, wid = __builtin_amdgcn_readfirstlane(tid >> 6), lane = tid & 63, wr = wid >> 2, wc = wid & 3, fr = lane & 15, fq = lane >> 4;
    const int K = g.K, nt = K / BK;
    unsigned voffA[2], voffB[2];
#pragma unroll
    for (int i = 0; i < 2; ++i) { int R, C; stage_rc(tid * 16 + i * 8192, R, C); const int Rb = Epi::PERM ? ((R & ~31) + perm32(R & 31)) : R;
        voffA[i] = (unsigned)(R * K + C) * 2u; voffB[i] = (unsigned)(Rb * K + C) * 2u; }
    const size_t kstep = (size_t)(BK * 2);
    const size_t hstep = (size_t)HALF * K * 2;
    const size_t tstep = 2 * hstep;
    const unsigned ldsw = (unsigned)wid * 1024u;
    const int aoff = lds_byte(wr * 64 + fr, fq * 8), boff = lds_byte(wc * 32 + fr, fq * 8);
#define PG8_SA(b, h) (((b) * 2 + (h)) * HTB)
#define PG8_SB(b, h) ((4 + (b) * 2 + (h)) * HTB)
#define PG8_STAGE(bufoff, gbase, voff) do { _Pragma("unroll") for (int _i = 0; _i < 2; ++_i) \
        __builtin_amdgcn_global_load_lds((const unsigned*)((const char*)(gbase) + (voff)[_i]), (PG8_LAS unsigned*)(lds + (bufoff) + ldsw + _i * 8192), 16, 0, 0); } while (0)
#define PG8_LDA(dst, b, h) do { _Pragma("unroll") for (int m = 0; m < 4; ++m) _Pragma("unroll") for (int k = 0; k < 2; ++k) dst[m][k] = *(const PG8_LAS bf16x8*)(lds + PG8_SA(b, h) + aoff + m * 2048 + k * 1024); } while (0)
#define PG8_LDB(dst, b, h) do { _Pragma("unroll") for (int n = 0; n < 2; ++n) _Pragma("unroll") for (int k = 0; k < 2; ++k) dst[n][k] = *(const PG8_LAS bf16x8*)(lds + PG8_SB(b, h) + boff + n * 2048 + k * 1024); } while (0)
#define PG8_MMA(ai, bj, At, Bt) do { __builtin_amdgcn_s_setprio(1); _Pragma("unroll") for (int m = 0; m < 4; ++m) _Pragma("unroll") for (int n = 0; n < 2; ++n) _Pragma("unroll") for (int k = 0; k < 2; ++k) \
        acc[ai][bj][m][n] = __builtin_amdgcn_mfma_f32_16x16x32_bf16(Bt[n][k], At[m][k], acc[ai][bj][m][n], 0, 0, 0); __builtin_amdgcn_s_setprio(0); } while (0)
#define PG8_WAIT_V(n) asm volatile("s_waitcnt vmcnt(" #n ")" ::: "memory")
#define PG8_WAIT_L(n) asm volatile("s_waitcnt lgkmcnt(" #n ")" ::: "memory")
#define PG8_BAR __builtin_amdgcn_s_barrier()
#define PG8_SCHED __builtin_amdgcn_sched_barrier(0)
    Unit cur, nxt; int ui = 0;
    if (!S.next(0, cur)) return;
    f32x4 acc[2][2][4][2];
#pragma unroll
    for (int a = 0; a < 2; ++a)
#pragma unroll
        for (int b = 0; b < 2; ++b)
#pragma unroll
            for (int m = 0; m < 4; ++m)
#pragma unroll
                for (int n = 0; n < 2; ++n) acc[a][b][m][n] = (f32x4){0.f, 0.f, 0.f, 0.f};
    bf16x8 At[4][2], B0[2][2], B1[2][2];
    const char* cA = (const char*)g.A + (size_t)cur.pm * tstep; const char* cB = (const char*)g.Bt + (size_t)cur.pn * tstep;
    S.a_ready(cur);
    if constexpr (SP2) {
        PG8_STAGE(PG8_SB(0, 0), cB, voffB); PG8_STAGE(PG8_SB(0, 1), cB + hstep, voffB); PG8_STAGE(PG8_SA(0, 0), cA, voffA); PG8_STAGE(PG8_SA(0, 1), cA + hstep, voffA);
        if (wr == 1) PG8_BAR;
        PG8_WAIT_V(2); PG8_BAR;
        PG8_STAGE(PG8_SB(1, 0), cB + kstep, voffB); PG8_STAGE(PG8_SA(1, 0), cA + kstep, voffA); PG8_STAGE(PG8_SB(1, 1), cB + hstep + kstep, voffB);
        PG8_WAIT_V(6); PG8_BAR;
    } else {
        PG8_STAGE(PG8_SB(0, 0), cB, voffB); PG8_STAGE(PG8_SA(0, 0), cA, voffA); PG8_STAGE(PG8_SB(0, 1), cB + hstep, voffB); PG8_STAGE(PG8_SA(0, 1), cA + hstep, voffA);
        if (wr == 1) PG8_BAR;
        PG8_WAIT_V(4); PG8_BAR;
        PG8_STAGE(PG8_SB(1, 0), cB + kstep, voffB); PG8_STAGE(PG8_SA(1, 0), cA + kstep, voffA); PG8_STAGE(PG8_SB(1, 1), cB + hstep + kstep, voffB);
        PG8_WAIT_V(6); PG8_BAR;
    }
    for (;;) {
        const bool has_next = S.next(ui + 1, nxt);
        const char* nA = has_next ? (const char*)g.A + (size_t)nxt.pm * tstep : cA; const char* nB = has_next ? (const char*)g.Bt + (size_t)nxt.pn * tstep : cB;
        for (int t = 0; t < nt; t += 2) {
            const bool last = (t == nt - 2);
            const char* a1 = cA + (size_t)(t + 1) * kstep;
            const char* a2 = last ? nA : cA + (size_t)(t + 2) * kstep; const char* b2 = last ? nB : cB + (size_t)(t + 2) * kstep;
            const char* a3 = a2 + kstep; const char* b3 = b2 + kstep;
            if (last && has_next) S.a_ready(nxt);
            if constexpr (SP2) {
            PG8_LDB(B0, 0, 0); PG8_LDB(B1, 0, 1); PG8_SCHED; PG8_LDA(At, 0, 0); PG8_STAGE(PG8_SA(1, 1), a1 + hstep, voffA);
            PG8_WAIT_V(8); PG8_WAIT_L(0); PG8_BAR; PG8_MMA(0, 0, At, B0); PG8_MMA(0, 1, At, B1); PG8_BAR; PG8_SCHED;
            PG8_LDA(At, 0, 1); PG8_STAGE(PG8_SB(0, 0), b2, voffB); PG8_STAGE(PG8_SB(0, 1), b2 + hstep, voffB); PG8_STAGE(PG8_SA(0, 0), a2, voffA);
            PG8_WAIT_V(8); PG8_WAIT_L(0); PG8_BAR; PG8_MMA(1, 0, At, B0); PG8_MMA(1, 1, At, B1); PG8_BAR; PG8_SCHED;
            PG8_LDB(B0, 1, 0); PG8_LDB(B1, 1, 1); PG8_SCHED; PG8_LDA(At, 1, 0); PG8_STAGE(PG8_SA(0, 1), a2 + hstep, voffA);
            PG8_WAIT_V(8); PG8_WAIT_L(0); PG8_BAR; PG8_MMA(0, 0, At, B0); PG8_MMA(0, 1, At, B1); PG8_BAR; PG8_SCHED;
            PG8_LDA(At, 1, 1); PG8_STAGE(PG8_SB(1, 0), b3, voffB); PG8_STAGE(PG8_SB(1, 1), b3 + hstep, voffB); PG8_STAGE(PG8_SA(1, 0), a3, voffA);
            PG8_WAIT_V(8); PG8_WAIT_L(0); PG8_BAR; PG8_MMA(1, 0, At, B0); PG8_MMA(1, 1, At, B1); PG8_BAR; PG8_SCHED;
            } else {
            PG8_LDB(B0, 0, 0); PG8_SCHED; PG8_LDA(At, 0, 0); PG8_STAGE(PG8_SA(1, 1), a1 + hstep, voffA);
            PG8_WAIT_L(8); PG8_BAR; PG8_WAIT_L(0); PG8_MMA(0, 0, At, B0); PG8_BAR; PG8_SCHED;
            PG8_LDB(B1, 0, 1); PG8_STAGE(PG8_SB(0, 0), b2, voffB);
            PG8_BAR; PG8_WAIT_L(0); PG8_MMA(0, 1, At, B1); PG8_BAR;
            PG8_LDA(At, 0, 1); PG8_STAGE(PG8_SA(0, 0), a2, voffA);
            PG8_BAR; PG8_WAIT_L(0); PG8_MMA(1, 0, At, B0); PG8_BAR; PG8_SCHED;
            PG8_STAGE(PG8_SB(0, 1), b2 + hstep, voffB);
            PG8_WAIT_V(6); PG8_BAR; PG8_MMA(1, 1, At, B1); PG8_BAR;
            PG8_LDB(B0, 1, 0); PG8_SCHED; PG8_LDA(At, 1, 0); PG8_STAGE(PG8_SA(0, 1), a2 + hstep, voffA);
            PG8_WAIT_L(8); PG8_BAR; PG8_WAIT_L(0); PG8_MMA(0, 0, At, B0); PG8_BAR; PG8_SCHED;
            PG8_LDB(B1, 1, 1); PG8_STAGE(PG8_SB(1, 0), b3, voffB);
            PG8_BAR; PG8_WAIT_L(0); PG8_MMA(0, 1, At, B1); PG8_BAR;
            PG8_LDA(At, 1, 1); PG8_STAGE(PG8_SA(1, 0), a3, voffA);
            PG8_BAR; PG8_WAIT_L(0); PG8_MMA(1, 0, At, B0); PG8_BAR; PG8_SCHED;
            PG8_STAGE(PG8_SB(1, 1), b3 + hstep, voffB);
            PG8_WAIT_V(6); PG8_BAR; PG8_MMA(1, 1, At, B1); PG8_BAR;
            }
        }
        if constexpr (ALIGN_EPI) { if (wr == 0) PG8_BAR; }
        if constexpr (!Epi::AFTER_DRAIN) { E(acc, cur, wr, wc, fr, fq); S.done(cur); }
        if (!has_next) break;
#pragma unroll
        for (int a = 0; a < 2; ++a)
#pragma unroll
            for (int b = 0; b < 2; ++b)
#pragma unroll
                for (int m = 0; m < 4; ++m)
#pragma unroll
                    for (int n = 0; n < 2; ++n) acc[a][b][m][n] = (f32x4){0.f, 0.f, 0.f, 0.f};
        cur = nxt; cA = nA; cB = nB; ++ui;
        if constexpr (ALIGN_EPI) { if (wr == 1) PG8_BAR; }
    }
    PG8_WAIT_V(0);
    if constexpr (!ALIGN_EPI) { if (wr == 0) PG8_BAR; }
    PG8_BAR;
    if constexpr (Epi::AFTER_DRAIN) { E.fused(acc, cur, wr, wc, fr, fq, lds, wid, lane); S.done(cur); }
#undef PG8_SA
#undef PG8_SB
#undef PG8_STAGE
#undef PG8_LDA
#undef PG8_LDB
#undef PG8_MMA
#undef PG8_WAIT_V
#undef PG8_WAIT_L
#undef PG8_BAR
#undef PG8_SCHED
}
}
#define GAS __attribute__((address_space(1)))
#define LAS __attribute__((address_space(3)))
typedef unsigned short bf16;
typedef unsigned v4u __attribute__((ext_vector_type(4)));
typedef unsigned v2u __attribute__((ext_vector_type(2)));
typedef float f32x4 __attribute__((ext_vector_type(4)));
typedef short bf16x8 __attribute__((ext_vector_type(8)));

constexpr int NWAVES = 8, NT = 512;
constexpr int D = 1024, NIN = 3072, FF = 4096, HD = 128, NH = 4, RW = 512, CW = 512, CK = 31;
constexpr int MMAIN = 16384, ROW_META = 16384, ROW_SMP = 16400, NREAL = 16912, R = 16960, MTAIL = R - MMAIN;
constexpr int NCH = 289;
constexpr float EPS = 1e-6f;
constexpr size_t MiB = 1u << 20;
constexpr size_t WS_WIN = 1 * MiB, WS_WOUT = 7 * MiB, WS_WMI = 9 * MiB, WS_WMO = 17 * MiB;
constexpr size_t WS_BUFA = 25 * MiB;
constexpr size_t WS_BUFB = 59 * MiB;
constexpr size_t WS_Q = 93 * MiB, WS_K = 110 * MiB, WS_V = 127 * MiB;
constexpr size_t WS_KVT = 144 * MiB;
constexpr size_t WS_ST = 209 * MiB;
constexpr size_t WS_HID = 93 * MiB;
constexpr size_t WS_END = 246 * MiB;
static_assert((size_t)R * 1024 * 2 <= 34 * MiB && (size_t)R * 512 * 2 <= 17 * MiB && (size_t)257 * 4 * 16384 * 4 <= 65 * MiB && (size_t)NCH * 4 * 16384 * 2 <= 37 * MiB && WS_HID + (size_t)R * 4096 * 2 <= WS_END, "ws map");
constexpr size_t O_YP = 0, O_YS = 16777216, O_SP = 17301504, O_CP = 17367040, O_SS = 17382400, O_CS = 19479552;
constexpr int LDS_BYTES = 147456;

__constant__ double c_invturn[64] = {0.15915494309189535, 0.13782250260398285, 0.11934937021124886, 0.10335229661843406, 0.08949940160889101, 0.07750328875537406, 0.06711508300522726, 0.058119267441876246, 0.050329212104487035, 0.04358330210530733, 0.03774158471741977, 0.032682865872357, 0.0283021958306234, 0.024508691862069852, 0.02122365276477766, 0.018378926105679667, 0.015915494309189534, 0.013782250260398284, 0.011934937021124886, 0.010335229661843406, 0.008949940160889102, 0.0077503288755374055, 0.006711508300522725, 0.005811926744187624, 0.005032921210448704, 0.004358330210530733, 0.003774158471741977, 0.0032682865872356993, 0.00283021958306234, 0.002450869186206985, 0.0021223652764777662, 0.0018378926105679667, 0.0015915494309189536, 0.0013782250260398288, 0.0011934937021124885, 0.0010335229661843405, 0.0008949940160889102, 0.0007750328875537405, 0.0006711508300522726, 0.0005811926744187624, 0.0005032921210448703, 0.0004358330210530733, 0.00037741584717419774, 0.0003268286587235699, 0.00028302195830623395, 0.00024508691862069854, 0.0002122365276477766, 0.00018378926105679666, 0.00015915494309189535, 0.00013782250260398286, 0.00011934937021124886, 0.00010335229661843406, 8.949940160889102e-05, 7.750328875537406e-05, 6.711508300522725e-05, 5.811926744187624e-05, 5.0329212104487035e-05, 4.358330210530732e-05, 3.774158471741978e-05, 3.2682865872357e-05, 2.8302195830623396e-05, 2.4508691862069852e-05, 2.122365276477766e-05, 1.8378926105679668e-05};

__device__ __forceinline__ float lg2gamma(int h) { return h == 0 ? -0.04580368961312479f : h == 1 ? -0.02272007650008353f : h == 2 ? -0.011315313227834146f : -0.005646563141142063f; }
__device__ __forceinline__ float ex2(float x) { return __builtin_amdgcn_exp2f(x); }
__device__ __forceinline__ unsigned f2bf(float f) { unsigned u = __builtin_bit_cast(unsigned, f); return (u + 0x7fffu + ((u >> 16) & 1u)) >> 16; }
__device__ __forceinline__ unsigned pk2(float lo, float hi) { return f2bf(lo) | (f2bf(hi) << 16); }
__device__ __forceinline__ float bflo(unsigned w) { return __builtin_bit_cast(float, w << 16); }
__device__ __forceinline__ float bfhi(unsigned w) { return __builtin_bit_cast(float, w & 0xffff0000u); }
__device__ __forceinline__ float bf1(bf16 h) { return __builtin_bit_cast(float, (unsigned)h << 16); }
__device__ __forceinline__ float sigmoidf_(float x) { return 1.0f / (1.0f + __expf(-x)); }
__device__ __forceinline__ float siluf_(float x) { return x / (1.0f + __expf(-x)); }
__device__ __forceinline__ float wave_sum(float v) {
#pragma unroll
    for (int o = 1; o < 64; o <<= 1) v += __shfl_xor(v, o);
    return v;
}
__device__ __forceinline__ int rowpos(int row) { return row < ROW_META ? 16 + row : (row < ROW_SMP ? row - ROW_META : 4112 + ((row - ROW_SMP) & 15)); }
__device__ __forceinline__ int dorig(int dp) { return (dp >> 1) + 64 * (dp & 1); }
__device__ __forceinline__ int win_src_col(int n) {
    if (n < 1024) return (n & ~127) + dorig(n & 127);
    if (n < 2048) return n;
    const int c = (n - 2048) >> 1; return (n & 1) ? 2560 + c : 2048 + c;
}

struct Frame {
    LAS unsigned char* lds;
    int tid, lane, wave, wg, nwg;
    const float *xp, *xs, *state, *cache, *meta, *g_pre_mix, *w_in, *gn_g, *gn_b, *dw_w, *dw_b, *cln_g, *cln_b, *w_out, *g_post_mix, *g_pre_mlp, *w_mi, *w_mo, *g_post_mlp;
    float* out;
    bf16 *Win_t, *Wout_t, *Wmi_t, *Wmo_t, *BufA, *BufB, *Ub, *Gb, *Qb, *Kb, *Vb, *St, *HID;
    float* KVt;
};
__device__ __forceinline__ const float* xrow(const Frame& F, int row) {
    if (row < ROW_META) return F.xp + (size_t)row * D;
    if (row < ROW_SMP) return F.meta + (size_t)(row - ROW_META) * D;
    return F.xs + (size_t)(row - ROW_SMP) * D;
}

struct FStore { bf16* O; int ldc;
    __device__ __forceinline__ void operator()(int row, int col, f32x4 v0, f32x4 v1) const {
        v4u w; w.x = pg8::cvt_pk_bf16(v0[0], v0[1]); w.y = pg8::cvt_pk_bf16(v0[2], v0[3]); w.z = pg8::cvt_pk_bf16(v1[0], v1[1]); w.w = pg8::cvt_pk_bf16(v1[2], v1[3]);
        *(v4u*)(O + (size_t)row * ldc + col) = w; } };
struct FRelu2 { bf16* O; int ldc;
    __device__ __forceinline__ void operator()(int row, int col, f32x4 v0, f32x4 v1) const {
#pragma unroll
        for (int t = 0; t < 4; ++t) { float a = fmaxf(v0[t], 0.f), b = fmaxf(v1[t], 0.f); v0[t] = a * a; v1[t] = b * b; }
        v4u w; w.x = pg8::cvt_pk_bf16(v0[0], v0[1]); w.y = pg8::cvt_pk_bf16(v0[2], v0[3]); w.z = pg8::cvt_pk_bf16(v1[0], v1[1]); w.w = pg8::cvt_pk_bf16(v1[2], v1[3]);
        *(v4u*)(O + (size_t)row * ldc + col) = w; } };
struct FProj { bf16 *Q, *K, *V, *G, *U;
    __device__ __forceinline__ void operator()(int row, int col, f32x4 v0, f32x4 v1) const {
        const int reg = col >> 9;
        float x[8] = {v0[0], v0[1], v0[2], v0[3], v1[0], v1[1], v1[2], v1[3]};
        if (reg < 2) {
            const int cc = col & 511, d0 = (cc & 127) >> 1;
            const double pos = (double)rowpos(row);
            const float sc = reg == 1 ? 0.08838834764831845f : 1.0f;
#pragma unroll
            for (int t = 0; t < 4; ++t) {
                double tu = pos * c_invturn[d0 + t]; tu -= __builtin_rint(tu);
                const float f = (float)tu, s = __builtin_amdgcn_sinf(f), c = __builtin_amdgcn_cosf(f);
                const float x1 = x[2 * t], x2 = x[2 * t + 1];
                x[2 * t] = (x1 * c - x2 * s) * sc; x[2 * t + 1] = (x2 * c + x1 * s) * sc;
            }
            v4u w; w.x = pg8::cvt_pk_bf16(x[0], x[1]); w.y = pg8::cvt_pk_bf16(x[2], x[3]); w.z = pg8::cvt_pk_bf16(x[4], x[5]); w.w = pg8::cvt_pk_bf16(x[6], x[7]);
            *(v4u*)((reg == 0 ? Q : K) + (size_t)row * 512 + cc) = w;
        } else if (reg < 4) {
            const int cc = col & 511;
            if (reg == 3) {
#pragma unroll
                for (int t = 0; t < 8; ++t) x[t] = siluf_(x[t]);
            }
            v4u w; w.x = pg8::cvt_pk_bf16(x[0], x[1]); w.y = pg8::cvt_pk_bf16(x[2], x[3]); w.z = pg8::cvt_pk_bf16(x[4], x[5]); w.w = pg8::cvt_pk_bf16(x[6], x[7]);
            *(v4u*)((reg == 2 ? V : G) + (size_t)row * 512 + cc) = w;
        } else {
            const int c0 = (col - 2048) >> 1;
            float u[4];
#pragma unroll
            for (int t = 0; t < 4; ++t) u[t] = x[2 * t] * sigmoidf_(x[2 * t + 1]);
            v2u w; w.x = pg8::cvt_pk_bf16(u[0], u[1]); w.y = pg8::cvt_pk_bf16(u[2], u[3]);
            *(v2u*)(U + (size_t)row * 512 + c0) = w;
        }
    } };
template <class Fn> struct EpiAd {
    static constexpr bool PERM = true, AFTER_DRAIN = false; Fn f;
    __device__ __forceinline__ void operator()(const f32x4 (&acc)[2][2][4][2], const pg8::Unit& u, int wr, int wc, int fr, int fq) const {
        const int row0 = u.pm * 256 + wr * 64 + fr, col0 = u.pn * 256 + wc * 32 + 8 * fq;
#pragma unroll
        for (int ai = 0; ai < 2; ++ai)
#pragma unroll
            for (int m = 0; m < 4; ++m)
#pragma unroll
                for (int bj = 0; bj < 2; ++bj) f(row0 + ai * 128 + m * 16, col0 + bj * 128, acc[ai][bj][m][0], acc[ai][bj][m][1]);
    } };

template <class Fn>
__device__ __forceinline__ void tail_gemm(const Frame& F, const bf16* A, const bf16* Bt, const int K, const int N, const Fn& f) {
    const int lane = F.lane, wave = F.wave, fr = lane & 15, fq = lane >> 4;
    const int nunits = (MTAIL / 32) * (N / 64), kw = K / 8;
    LAS f32x4* red = (LAS f32x4*)F.lds;
    for (int u = F.wg; u < nunits; u += F.nwg) {
        const int nb = u / (MTAIL / 32), mb = u % (MTAIL / 32), rb = MMAIN + 32 * mb, cb = 64 * nb;
        f32x4 acc[2][2][2];
#pragma unroll
        for (int i = 0; i < 8; ++i) acc[i >> 2][(i >> 1) & 1][i & 1] = (f32x4){0.f, 0.f, 0.f, 0.f};
        const bf16* ap = A + (size_t)(rb + fr) * K + wave * kw + 8 * fq;
        const bf16* bp = Bt + (size_t)(cb + 8 * (fr >> 2) + (fr & 3)) * K + wave * kw + 8 * fq;
#pragma unroll 4
        for (int ks = 0; ks < kw / 32; ++ks) {
            bf16x8 a[2], b[2][2];
#pragma unroll
            for (int mi = 0; mi < 2; ++mi) a[mi] = *(const bf16x8*)(ap + (size_t)mi * 16 * K + ks * 32);
#pragma unroll
            for (int g = 0; g < 2; ++g)
#pragma unroll
                for (int n = 0; n < 2; ++n) b[g][n] = *(const bf16x8*)(bp + (size_t)(32 * g + 4 * n) * K + ks * 32);
#pragma unroll
            for (int mi = 0; mi < 2; ++mi)
#pragma unroll
                for (int g = 0; g < 2; ++g)
#pragma unroll
                    for (int n = 0; n < 2; ++n) acc[mi][g][n] = __builtin_amdgcn_mfma_f32_16x16x32_bf16(b[g][n], a[mi], acc[mi][g][n], 0, 0, 0);
        }
#pragma unroll
        for (int i = 0; i < 8; ++i) red[(wave * 8 + i) * 64 + lane] = acc[i >> 2][(i >> 1) & 1][i & 1];
        __syncthreads();
        if (wave < 4) {
            const int mi = wave >> 1, g = wave & 1;
            f32x4 v0 = (f32x4){0.f, 0.f, 0.f, 0.f}, v1 = v0;
#pragma unroll
            for (int w = 0; w < 8; ++w) { v0 += red[(w * 8 + (mi * 2 + g) * 2 + 0) * 64 + lane]; v1 += red[(w * 8 + (mi * 2 + g) * 2 + 1) * 64 + lane]; }
            f(rb + 16 * mi + fr, cb + 32 * g + 8 * fq, v0, v1);
        }
        __syncthreads();
    }
}
#define XB_TMO      128
#define XB_XCNT(j)  (256  + 64 * (j))
#define XB_XSUB(j)  (1280 + 64 * (j))
#define XB_XGEN(j)  (2304 + 64 * (j))
#define XB_TOP      3328
#define XB_TOPGEN   3392
#define XCD_BAR_WORDS 3456
#define XB_SPIN_CAP (1u << 18)

__device__ __forceinline__ unsigned xb_ld(unsigned* p)              { return __hip_atomic_load(p, __ATOMIC_RELAXED, __HIP_MEMORY_SCOPE_AGENT); }
__device__ __forceinline__ unsigned xb_add(unsigned* p, unsigned v) { return __hip_atomic_fetch_add(p, v, __ATOMIC_RELAXED, __HIP_MEMORY_SCOPE_AGENT); }
__device__ __forceinline__ unsigned xb_xcc_id() { return (unsigned)__builtin_amdgcn_s_getreg((3 << 11) | 20) & 0xFu; }
#define XB_SPIN(cond, bar) do { unsigned _sp = 0; while (cond) { __builtin_amdgcn_s_sleep(1); \
    if ((++_sp & 255u) == 0u) { if (xb_ld(&(bar)[XB_TMO])) break; if (_sp > XB_SPIN_CAP) { atomicAdd(&(bar)[XB_TMO], 1u); break; } } } } while (0)

struct XcdBarrier {
    unsigned* bar; unsigned x;
    volatile LAS unsigned* st;
};

__device__ __forceinline__ XcdBarrier xcd_barrier_post(unsigned* bar, volatile LAS unsigned* st) {
    XcdBarrier b; b.bar = bar; b.x = xb_xcc_id(); b.st = st;
    if (threadIdx.x == 0) (void)xb_add(&bar[XB_XCNT(b.x)], 1u);
    return b;
}
__device__ __forceinline__ void xcd_barrier_complete(unsigned* bar, unsigned x, unsigned& nloc, unsigned& nx) {
    const unsigned G = gridDim.x * gridDim.y * gridDim.z;
    unsigned sum, cnt, mine, sp = 0u;
    for (;;) {
        sum = 0u; cnt = 0u; mine = 0u;
#pragma unroll
        for (unsigned j = 0; j < 16; ++j) { const unsigned c = xb_ld(&bar[XB_XCNT(j)]); sum += c; cnt += (c > 0u) ? 1u : 0u; mine = (j == x) ? c : mine; }
        if (sum == G) break;
        __builtin_amdgcn_s_sleep(1);
        if ((++sp & 255u) == 0u) { if (xb_ld(&bar[XB_TMO])) break; if (sp > XB_SPIN_CAP) { atomicAdd(&bar[XB_TMO], 1u); break; } }
    }
    nloc = mine > 0u ? mine : 1u; nx = cnt > 0u ? cnt : 1u;
}

__device__ __forceinline__ void xcd_barrier(const XcdBarrier& b) {
    asm volatile("s_waitcnt vmcnt(0)" ::: "memory");
    __syncthreads();
    if (threadIdx.x == 0) {
        unsigned* bar = b.bar;
        __builtin_amdgcn_s_waitcnt(0);
        unsigned nloc = b.st[0], nx = b.st[1];
        if (nloc == 0u) { xcd_barrier_complete(bar, b.x, nloc, nx); b.st[0] = nloc; b.st[1] = nx; }
        const unsigned old = xb_add(&bar[XB_XSUB(b.x)], 1u);
        const unsigned gen = old / nloc;
        if (old + 1u == (gen + 1u) * nloc) {
            __builtin_amdgcn_fence(__ATOMIC_RELEASE, "agent");
            asm volatile("s_waitcnt vmcnt(0)" ::: "memory");
            const unsigned og = xb_add(&bar[XB_TOP], 1u);
            const unsigned tg = og / nx;
            if (og + 1u == (tg + 1u) * nx) xb_add(&bar[XB_TOPGEN], 1u);
            else XB_SPIN(xb_ld(&bar[XB_TOPGEN]) == tg, bar);
            __builtin_amdgcn_fence(__ATOMIC_ACQUIRE, "agent");
            xb_add(&bar[XB_XGEN(b.x)], 1u);
            asm volatile("s_waitcnt vmcnt(0)" ::: "memory");
        } else {
            XB_SPIN(xb_ld(&bar[XB_XGEN(b.x)]) == gen, bar);
            __builtin_amdgcn_fence(__ATOMIC_ACQUIRE, "agent");
            asm volatile("s_waitcnt vmcnt(0)" ::: "memory");
        }
    }
    __syncthreads();
}

template <bool PERMIN>
__device__ __forceinline__ void p0_transpose_item(const float* W, int K, int N, bf16* WT, LAS float* scr, int item, int lane) {
    const int nblk = N / 32, kb = item / nblk, nb = item % nblk, k0 = 64 * kb, n0 = 32 * nb;
    const int nsrc = PERMIN ? win_src_col(n0 + (lane & 31)) : n0 + (lane & 31);
#pragma unroll 8
    for (int i = 0; i < 32; ++i) { const int kk = 2 * i + (lane >> 5); scr[kk * 33 + (lane & 31)] = W[(size_t)(k0 + kk) * N + nsrc]; }
    asm volatile("s_waitcnt lgkmcnt(0)" ::: "memory");
    const int c = lane & 7;
#pragma unroll
    for (int j = 0; j < 4; ++j) { const int n = (lane >> 3) + 8 * j; const LAS float* s = scr + (8 * c) * 33 + n;
        v4u o; o.x = pk2(s[0 * 33], s[1 * 33]); o.y = pk2(s[2 * 33], s[3 * 33]); o.z = pk2(s[4 * 33], s[5 * 33]); o.w = pk2(s[6 * 33], s[7 * 33]);
        *(v4u*)(WT + (size_t)(n0 + n) * K + k0 + 8 * c) = o; }
    asm volatile("s_waitcnt lgkmcnt(0)" ::: "memory");
}
__device__ __forceinline__ void rms_row_to_bf16(const float* xr_, const float* g, bf16* orow, int lane) {
    const f32x4* xr = (const f32x4*)xr_ + lane; const f32x4* gr = (const f32x4*)g + lane;
    f32x4 v[4]; float s = 0.f;
#pragma unroll
    for (int j = 0; j < 4; ++j) { v[j] = xr[64 * j]; s += (v[j].x * v[j].x + v[j].y * v[j].y) + (v[j].z * v[j].z + v[j].w * v[j].w); }
    const float rs = 1.0f / sqrtf(wave_sum(s) * (1.f / D) + EPS);
    unsigned long long* o8 = (unsigned long long*)orow + lane;
#pragma unroll
    for (int j = 0; j < 4; ++j) { const f32x4 gg = gr[64 * j];
        o8[64 * j] = (unsigned long long)pk2(v[j].x * rs * gg.x, v[j].y * rs * gg.y) | ((unsigned long long)pk2(v[j].z * rs * gg.z, v[j].w * rs * gg.w) << 32); }
}
__device__ __forceinline__ void p0_prologue(const Frame& F) {
    LAS float* scr = (LAS float*)(F.lds + F.wave * 16384);
    const int gw = F.wg * NWAVES + F.wave, NGW = F.nwg * NWAVES;
    constexpr int I_IN = (D / 64) * (NIN / 32), I_O = (D / 64) * (D / 32), I_1 = (D / 64) * (FF / 32), I_2 = (FF / 64) * (D / 32);
    constexpr int NITEMS = I_IN + I_O + I_1 + I_2;
    for (int it = gw; it < NITEMS; it += NGW) {
        int r = it;
        if (r < I_IN) { p0_transpose_item<true>(F.w_in, D, NIN, F.Win_t, scr, r, F.lane); continue; } r -= I_IN;
        if (r < I_O) { p0_transpose_item<false>(F.w_out, D, D, F.Wout_t, scr, r, F.lane); continue; } r -= I_O;
        if (r < I_1) { p0_transpose_item<false>(F.w_mi, D, FF, F.Wmi_t, scr, r, F.lane); continue; } r -= I_1;
        p0_transpose_item<false>(F.w_mo, FF, D, F.Wmo_t, scr, r, F.lane);
    }
    for (int m = gw; m < R; m += NGW) {
        if (m < NREAL) rms_row_to_bf16(xrow(F, m), F.g_pre_mix, F.BufA + (size_t)m * D, F.lane);
        else { unsigned long long* o8 = (unsigned long long*)(F.BufA + (size_t)m * D) + F.lane;
#pragma unroll
            for (int j = 0; j < 4; ++j) o8[64 * j] = 0ull; }
    }
}

__device__ __forceinline__ void chunk_geom(int cid, int& row0, int& off) {
    if (cid == 0) { row0 = ROW_META - 48; off = 48; }
    else if (cid <= 256) { row0 = (cid - 1) * 64; off = 0; }
    else { row0 = ROW_SMP + (cid - 257) * 16 - 48; off = 48; }
}

constexpr int TS = 130;
__device__ __forceinline__ bf16x8 gather_col(const LAS bf16* T, int r0, int c) {
    bf16x8 v;
#pragma unroll
    for (int t = 0; t < 8; ++t) v[t] = (short)T[(r0 + t) * TS + c];
    return v;
}
__device__ __forceinline__ void lds_put16(LAS bf16* T, int r, int c8, v4u w) {
    LAS unsigned* p = (LAS unsigned*)(T + r * TS + c8);
    p[0] = w.x; p[1] = w.y; p[2] = w.z; p[3] = w.w;
}
__device__ __forceinline__ void kv_unit(const Frame& F, int cid, int h) {
    LAS bf16* Ks = (LAS bf16*)F.lds; LAS bf16* Vs = Ks + 64 * TS;
    int row0, off; chunk_geom(cid, row0, off);
    const float lg = lg2gamma(h);
    __syncthreads();
#pragma unroll
    for (int i = 0; i < 2; ++i) {
        const int p = F.tid + NT * i, j = p >> 4, seg = p & 15;
        v4u kw = (v4u){0u, 0u, 0u, 0u}, vw = kw;
        if (j >= off) {
            kw = *(const v4u*)(F.Kb + (size_t)(row0 + j) * 512 + h * 128 + seg * 8);
            vw = *(const v4u*)(F.Vb + (size_t)(row0 + j) * 512 + h * 128 + seg * 8);
            const float w = ex2(lg * (float)(63 - j));
            kw.x = pk2(bflo(kw.x) * w, bfhi(kw.x) * w); kw.y = pk2(bflo(kw.y) * w, bfhi(kw.y) * w); kw.z = pk2(bflo(kw.z) * w, bfhi(kw.z) * w); kw.w = pk2(bflo(kw.w) * w, bfhi(kw.w) * w);
        }
        lds_put16(Ks, j, seg * 8, kw); lds_put16(Vs, j, seg * 8, vw);
    }
    __syncthreads();
    const int fr = F.lane & 15, fq = F.lane >> 4, e0 = 16 * F.wave;
    f32x4 acc[8];
#pragma unroll
    for (int db = 0; db < 8; ++db) acc[db] = (f32x4){0.f, 0.f, 0.f, 0.f};
#pragma unroll
    for (int ks = 0; ks < 2; ++ks) {
        const bf16x8 vf = gather_col(Vs, 32 * ks + 8 * fq, e0 + fr);
#pragma unroll
        for (int db = 0; db < 8; ++db) { const bf16x8 kf = gather_col(Ks, 32 * ks + 8 * fq, 16 * db + fr);
            acc[db] = __builtin_amdgcn_mfma_f32_16x16x32_bf16(kf, vf, acc[db], 0, 0, 0); asm volatile("" ::: "memory"); }
    }
    if (cid <= 256) {
        float* o = F.KVt + ((size_t)(cid * 4 + h) * 128 + e0 + fr) * 128 + 4 * fq;
#pragma unroll
        for (int db = 0; db < 8; ++db) *(f32x4*)(o + 16 * db) = acc[db];
    } else {
        const int b = cid - 257; const float g16 = ex2(lg * 16.0f);
        const size_t base = (size_t)(b * 4 + h) * 16384;
#pragma unroll
        for (int db = 0; db < 8; ++db)
#pragma unroll
            for (int r = 0; r < 4; ++r) { const size_t idx = base + (size_t)dorig(16 * db + 4 * fq + r) * 128 + e0 + fr;
                F.out[O_SS + idx] = g16 * F.state[idx] + acc[db][r]; }
#pragma unroll
        for (int i = 0; i < 4; ++i) {
            const int p = F.tid + NT * i, seg = p >> 7, e = p & 127;
            float s[8];
#pragma unroll
            for (int t = 0; t < 8; ++t) s[t] = F.state[base + (size_t)dorig(8 * seg + t) * 128 + e];
            v4u w; w.x = pk2(s[0], s[1]); w.y = pk2(s[2], s[3]); w.z = pk2(s[4], s[5]); w.w = pk2(s[6], s[7]);
            *(v4u*)(F.St + ((size_t)(cid * 4 + h) * 128 + e) * 128 + 8 * seg) = w;
        }
    }
}

template <int RPW>
__device__ __forceinline__ void conv_compute(const Frame& F, const LAS bf16* us, const LAS bf16* wts, int rowbase) {
    const int c0 = F.lane * 8, r0 = F.wave * RPW;
    float acc[RPW][8];
    { const f32x4 b0 = *(const f32x4*)(F.dw_b + c0), b1 = *(const f32x4*)(F.dw_b + c0 + 4);
#pragma unroll
      for (int o = 0; o < RPW; ++o) { acc[o][0] = b0.x; acc[o][1] = b0.y; acc[o][2] = b0.z; acc[o][3] = b0.w; acc[o][4] = b1.x; acc[o][5] = b1.y; acc[o][6] = b1.z; acc[o][7] = b1.w; } }
#pragma unroll 1
    for (int tap = 0; tap < CK; ++tap) {
        const v4u ww = *(const LAS v4u*)(wts + tap * 512 + c0);
        const float w[8] = {bflo(ww.x), bfhi(ww.x), bflo(ww.y), bfhi(ww.y), bflo(ww.z), bfhi(ww.z), bflo(ww.w), bfhi(ww.w)};
#pragma unroll
        for (int o = 0; o < RPW; ++o) {
            const v4u uu = *(const LAS v4u*)(us + (r0 + o + tap) * 512 + c0);
            acc[o][0] += w[0] * bflo(uu.x); acc[o][1] += w[1] * bfhi(uu.x); acc[o][2] += w[2] * bflo(uu.y); acc[o][3] += w[3] * bfhi(uu.y);
            acc[o][4] += w[4] * bflo(uu.z); acc[o][5] += w[5] * bfhi(uu.z); acc[o][6] += w[6] * bflo(uu.w); acc[o][7] += w[7] * bfhi(uu.w);
        }
    }
    const f32x4 g0 = *(const f32x4*)(F.cln_g + c0), g1 = *(const f32x4*)(F.cln_g + c0 + 4), b0 = *(const f32x4*)(F.cln_b + c0), b1 = *(const f32x4*)(F.cln_b + c0 + 4);
    const float g[8] = {g0.x, g0.y, g0.z, g0.w, g1.x, g1.y, g1.z, g1.w}, bb[8] = {b0.x, b0.y, b0.z, b0.w, b1.x, b1.y, b1.z, b1.w};
#pragma unroll
    for (int o = 0; o < RPW; ++o) {
        float s = 0.f;
#pragma unroll
        for (int t = 0; t < 8; ++t) s += acc[o][t];
        const float mu = wave_sum(s) * (1.f / CW);
        float q = 0.f;
#pragma unroll
        for (int t = 0; t < 8; ++t) { const float dlt = acc[o][t] - mu; q += dlt * dlt; }
        const float rs = 1.0f / sqrtf(wave_sum(q) * (1.f / CW) + EPS);
        float y[8];
#pragma unroll
        for (int t = 0; t < 8; ++t) y[t] = siluf_((acc[o][t] - mu) * rs * g[t] + bb[t]);
        v4u w; w.x = pk2(y[0], y[1]); w.y = pk2(y[2], y[3]); w.z = pk2(y[4], y[5]); w.w = pk2(y[6], y[7]);
        *(v4u*)(F.BufA + (size_t)(rowbase + r0 + o) * D + 512 + c0) = w;
    }
}
__device__ __forceinline__ void conv_unit(const Frame& F, int cid) {
    LAS bf16* us = (LAS bf16*)F.lds;
    LAS bf16* wts = us + 94 * 512;
    const int L = (cid >= 1 && cid <= 256) ? 64 : 16;
    const int rowbase = cid == 0 ? ROW_META : (cid <= 256 ? (cid - 1) * 64 : ROW_SMP + (cid - 257) * 16);
    __syncthreads();
    for (int p = F.tid; p < (30 + L) * 64; p += NT) {
        const int x = p >> 6, seg = p & 63;
        v4u w = (v4u){0u, 0u, 0u, 0u};
        if (x >= 30) w = *(const v4u*)(F.Ub + (size_t)(rowbase + x - 30) * 512 + seg * 8);
        else if (cid > 256) { const float* s = F.cache + ((size_t)(cid - 257) * 30 + x) * 512 + seg * 8; const f32x4 a = *(const f32x4*)s, b = *(const f32x4*)(s + 4);
            w.x = pk2(a.x, a.y); w.y = pk2(a.z, a.w); w.z = pk2(b.x, b.y); w.w = pk2(b.z, b.w); }
        else if (cid >= 1) { const int pos = 16 + (cid - 1) * 64 - 30 + x;
            if (pos >= 0) { const int row = pos < 16 ? ROW_META + pos : pos - 16; w = *(const v4u*)(F.Ub + (size_t)row * 512 + seg * 8); } }
        *(LAS v4u*)(us + x * 512 + seg * 8) = w;
    }
    for (int p = F.tid; p < CK * 64; p += NT) { const float* s = F.dw_w + (size_t)p * 8; const f32x4 a = *(const f32x4*)s, b = *(const f32x4*)(s + 4);
        v4u w; w.x = pk2(a.x, a.y); w.y = pk2(a.z, a.w); w.z = pk2(b.x, b.y); w.w = pk2(b.z, b.w); *(LAS v4u*)(wts + p * 8) = w; }
    __syncthreads();
    if (L == 64) conv_compute<8>(F, us, wts, rowbase); else conv_compute<2>(F, us, wts, rowbase);
    if (cid == 256) {
        for (int i = F.tid; i < 30 * 512; i += NT) F.out[O_CP + i] = bf1(us[64 * 512 + i]);
    } else if (cid > 256) {
        const int b = cid - 257;
        for (int i = F.tid; i < 30 * 512; i += NT) { const int r = i >> 9;
            F.out[O_CS + (size_t)b * 30 * 512 + i] = r < 14 ? F.cache[((size_t)b * 30 + 16) * 512 + i] : bf1(us[16 * 512 + i]); }
    }
}

__device__ __forceinline__ void scan_phase(const Frame& F) {
    if (F.tid >= 256) return;
    for (int el = F.wg * 256 + F.tid; el < 65536; el += F.nwg * 256) {
        const int h = el >> 14, within = el & 16383, e = within >> 7, dp = within & 127;
        const float a = ex2(lg2gamma(h) * 64.0f);
        float s = 0.f;
        const float* kv = F.KVt + (size_t)h * 16384 + within; bf16* st = F.St + (size_t)h * 16384 + within;
        for (int c0 = 0; c0 < 256; c0 += 32) {
            float v[32];
#pragma unroll
            for (int i = 0; i < 32; ++i) v[i] = kv[(size_t)(c0 + i) * 65536];
#pragma unroll
            for (int i = 0; i < 32; ++i) { st[(size_t)(c0 + i) * 65536] = (bf16)f2bf(s); s = a * s + v[i]; }
        }
        st[(size_t)256 * 65536] = (bf16)f2bf(s); s = a * s + kv[(size_t)256 * 65536];
        F.out[O_SP + (size_t)(h * 128 + dorig(dp)) * 128 + e] = s;
    }
}

constexpr int PS = 72;
__device__ __forceinline__ void ret_unit(const Frame& F, int cid, int hp) {
    LAS bf16* Vs = (LAS bf16*)F.lds;
    LAS bf16* Pw = (LAS bf16*)(F.lds + 2 * 64 * TS * 2) + F.wave * 16 * PS;
    int row0, off; chunk_geom(cid, row0, off);
    __syncthreads();
#pragma unroll
    for (int i = 0; i < 4; ++i) {
        const int p = F.tid + NT * i, hh = p >> 10, j = (p >> 4) & 63, seg = p & 15;
        v4u vw = (v4u){0u, 0u, 0u, 0u};
        if (j >= off) vw = *(const v4u*)(F.Vb + (size_t)(row0 + j) * 512 + (2 * hp + hh) * 128 + seg * 8);
        lds_put16(Vs + hh * 64 * TS, j, seg * 8, vw);
    }
    __syncthreads();
    const int fr = F.lane & 15, fq = F.lane >> 4, hh = F.wave >> 2, ib = F.wave & 3, h = 2 * hp + hh;
    const int i_loc = 16 * ib + fr;
    const bool ivalid = i_loc >= off;
    const float lg = lg2gamma(h);
    bf16x8 qf[4];
#pragma unroll
    for (int ks = 0; ks < 4; ++ks) { qf[ks] = (bf16x8){0, 0, 0, 0, 0, 0, 0, 0};
        if (ivalid) qf[ks] = *(const bf16x8*)(F.Qb + (size_t)(row0 + i_loc) * 512 + h * 128 + 32 * ks + 8 * fq); }
    f32x4 sc[4];
#pragma unroll
    for (int jb = 0; jb < 4; ++jb) { sc[jb] = (f32x4){0.f, 0.f, 0.f, 0.f};
        const int j = 16 * jb + fr;
#pragma unroll
        for (int ks = 0; ks < 4; ++ks) { bf16x8 kf = (bf16x8){0, 0, 0, 0, 0, 0, 0, 0};
            if (j >= off) kf = *(const bf16x8*)(F.Kb + (size_t)(row0 + j) * 512 + h * 128 + 32 * ks + 8 * fq);
            sc[jb] = __builtin_amdgcn_mfma_f32_16x16x32_bf16(kf, qf[ks], sc[jb], 0, 0, 0); } }
#pragma unroll
    for (int jb = 0; jb < 4; ++jb) { float pv[4];
#pragma unroll
        for (int r = 0; r < 4; ++r) { const int j = 16 * jb + 4 * fq + r; const int dd = i_loc > j ? i_loc - j : j - i_loc; pv[r] = sc[jb][r] * ex2(lg * (float)dd); }
        v2u w; w.x = pk2(pv[0], pv[1]); w.y = pk2(pv[2], pv[3]);
        *(LAS v2u*)(Pw + fr * PS + 16 * jb + 4 * fq) = w; }
    asm volatile("s_waitcnt lgkmcnt(0)" ::: "memory");
    f32x4 ao[8], ai[8];
#pragma unroll
    for (int eb = 0; eb < 8; ++eb) { ao[eb] = (f32x4){0.f, 0.f, 0.f, 0.f}; ai[eb] = ao[eb]; }
#pragma unroll
    for (int ks = 0; ks < 2; ++ks) {
        const bf16x8 pf = *(const LAS bf16x8*)(Pw + fr * PS + 32 * ks + 8 * fq);
#pragma unroll
        for (int eb = 0; eb < 8; ++eb) { const bf16x8 vf = gather_col(Vs + hh * 64 * TS, 32 * ks + 8 * fq, 16 * eb + fr);
            ao[eb] = __builtin_amdgcn_mfma_f32_16x16x32_bf16(vf, pf, ao[eb], 0, 0, 0); }
    }
    const bf16* st = F.St + ((size_t)(cid * 4 + h) * 128 + fr) * 128 + 8 * fq;
#pragma unroll
    for (int eb = 0; eb < 8; ++eb)
#pragma unroll
        for (int ks = 0; ks < 4; ++ks) { const bf16x8 sf = *(const bf16x8*)(st + (size_t)(16 * eb) * 128 + 32 * ks);
            ai[eb] = __builtin_amdgcn_mfma_f32_16x16x32_bf16(sf, qf[ks], ai[eb], 0, 0, 0); }
    const float din = ex2(lg * (float)(i_loc - off + 1));
    float s = 0.f;
#pragma unroll
    for (int eb = 0; eb < 8; ++eb) { ao[eb] = ao[eb] + ai[eb] * din; s += (ao[eb][0] + ao[eb][1]) + (ao[eb][2] + ao[eb][3]); }
    s += __shfl_xor(s, 16); s += __shfl_xor(s, 32);
    const float mu = s * (1.f / HD);
    float q = 0.f;
#pragma unroll
    for (int eb = 0; eb < 8; ++eb) { const f32x4 dlt = ao[eb] - mu; q += (dlt[0] * dlt[0] + dlt[1] * dlt[1]) + (dlt[2] * dlt[2] + dlt[3] * dlt[3]); }
    q += __shfl_xor(q, 16); q += __shfl_xor(q, 32);
    const float rs = 1.0f / sqrtf(q * (1.f / HD) + EPS);
    if (ivalid) {
        const int row = row0 + i_loc;
#pragma unroll
        for (int eb = 0; eb < 8; ++eb) { const int c = h * 128 + 16 * eb + 4 * fq;
            const f32x4 gg = *(const f32x4*)(F.gn_g + c), gb = *(const f32x4*)(F.gn_b + c);
            const v2u sg = *(const v2u*)(F.Gb + (size_t)row * 512 + c);
            const f32x4 rn = (ao[eb] - mu) * rs * gg + gb;
            v2u w; w.x = pk2(rn[0] * bflo(sg.x), rn[1] * bfhi(sg.x)); w.y = pk2(rn[2] * bflo(sg.y), rn[3] * bfhi(sg.y));
            *(v2u*)(F.BufA + (size_t)row * D + c) = w; }
    }
}

__device__ __forceinline__ void rowpass1(const Frame& F) {
    const int gw = F.wg * NWAVES + F.wave, NGW = F.nwg * NWAVES;
    for (int row = gw; row < NREAL; row += NGW) {
        const float* xr = xrow(F, row);
        float m[16], x[16]; float ss = 0.f;
#pragma unroll
        for (int i = 0; i < 2; ++i) { const int c = 512 * i + 8 * F.lane;
            const v4u w = *(const v4u*)(F.BufB + (size_t)row * D + c);
            m[8 * i + 0] = bflo(w.x); m[8 * i + 1] = bfhi(w.x); m[8 * i + 2] = bflo(w.y); m[8 * i + 3] = bfhi(w.y); m[8 * i + 4] = bflo(w.z); m[8 * i + 5] = bfhi(w.z); m[8 * i + 6] = bflo(w.w); m[8 * i + 7] = bfhi(w.w);
            const f32x4 a = *(const f32x4*)(xr + c), b = *(const f32x4*)(xr + c + 4);
            x[8 * i + 0] = a.x; x[8 * i + 1] = a.y; x[8 * i + 2] = a.z; x[8 * i + 3] = a.w; x[8 * i + 4] = b.x; x[8 * i + 5] = b.y; x[8 * i + 6] = b.z; x[8 * i + 7] = b.w; }
#pragma unroll
        for (int t = 0; t < 16; ++t) ss += m[t] * m[t];
        const float rs1 = 1.0f / sqrtf(wave_sum(ss) * (1.f / D) + EPS);
        float s2 = 0.f;
#pragma unroll
        for (int i = 0; i < 2; ++i) { const int c = 512 * i + 8 * F.lane; const f32x4 ga = *(const f32x4*)(F.g_post_mix + c), gb = *(const f32x4*)(F.g_post_mix + c + 4);
            const float g[8] = {ga.x, ga.y, ga.z, ga.w, gb.x, gb.y, gb.z, gb.w};
#pragma unroll
            for (int t = 0; t < 8; ++t) { x[8 * i + t] += m[8 * i + t] * rs1 * g[t]; s2 += x[8 * i + t] * x[8 * i + t]; } }
        const float rs2 = 1.0f / sqrtf(wave_sum(s2) * (1.f / D) + EPS);
        float* xo = row < ROW_META ? F.out + O_YP + (size_t)row * D : (row >= ROW_SMP ? F.out + O_YS + (size_t)(row - ROW_SMP) * D : nullptr);
#pragma unroll
        for (int i = 0; i < 2; ++i) { const int c = 512 * i + 8 * F.lane; const f32x4 ga = *(const f32x4*)(F.g_pre_mlp + c), gb = *(const f32x4*)(F.g_pre_mlp + c + 4);
            const float g[8] = {ga.x, ga.y, ga.z, ga.w, gb.x, gb.y, gb.z, gb.w};
            if (xo) { *(f32x4*)(xo + c) = (f32x4){x[8 * i], x[8 * i + 1], x[8 * i + 2], x[8 * i + 3]}; *(f32x4*)(xo + c + 4) = (f32x4){x[8 * i + 4], x[8 * i + 5], x[8 * i + 6], x[8 * i + 7]}; }
            v4u w; w.x = pk2(x[8 * i] * rs2 * g[0], x[8 * i + 1] * rs2 * g[1]); w.y = pk2(x[8 * i + 2] * rs2 * g[2], x[8 * i + 3] * rs2 * g[3]);
            w.z = pk2(x[8 * i + 4] * rs2 * g[4], x[8 * i + 5] * rs2 * g[5]); w.w = pk2(x[8 * i + 6] * rs2 * g[6], x[8 * i + 7] * rs2 * g[7]);
            *(v4u*)(F.BufA + (size_t)row * D + c) = w; }
    }
}
__device__ __forceinline__ void rowpass2(const Frame& F) {
    const int gw = F.wg * NWAVES + F.wave, NGW = F.nwg * NWAVES;
    for (int row = gw; row < NREAL; row += NGW) {
        if (row >= ROW_META && row < ROW_SMP) continue;
        float* xo = row < ROW_META ? F.out + O_YP + (size_t)row * D : F.out + O_YS + (size_t)(row - ROW_SMP) * D;
        float m[16]; float ss = 0.f;
#pragma unroll
        for (int i = 0; i < 2; ++i) { const int c = 512 * i + 8 * F.lane;
            const v4u w = *(const v4u*)(F.BufA + (size_t)row * D + c);
            m[8 * i + 0] = bflo(w.x); m[8 * i + 1] = bfhi(w.x); m[8 * i + 2] = bflo(w.y); m[8 * i + 3] = bfhi(w.y); m[8 * i + 4] = bflo(w.z); m[8 * i + 5] = bfhi(w.z); m[8 * i + 6] = bflo(w.w); m[8 * i + 7] = bfhi(w.w); }
#pragma unroll
        for (int t = 0; t < 16; ++t) ss += m[t] * m[t];
        const float rs = 1.0f / sqrtf(wave_sum(ss) * (1.f / D) + EPS);
#pragma unroll
        for (int i = 0; i < 2; ++i) { const int c = 512 * i + 8 * F.lane; const f32x4 ga = *(const f32x4*)(F.g_post_mlp + c), gb = *(const f32x4*)(F.g_post_mlp + c + 4);
            f32x4 a = *(const f32x4*)(xo + c), b = *(const f32x4*)(xo + c + 4);
            a.x += m[8 * i] * rs * ga.x; a.y += m[8 * i + 1] * rs * ga.y; a.z += m[8 * i + 2] * rs * ga.z; a.w += m[8 * i + 3] * rs * ga.w;
            b.x += m[8 * i + 4] * rs * gb.x; b.y += m[8 * i + 5] * rs * gb.y; b.z += m[8 * i + 6] * rs * gb.z; b.w += m[8 * i + 7] * rs * gb.w;
            *(f32x4*)(xo + c) = a; *(f32x4*)(xo + c + 4) = b; }
    }
}

__device__ __forceinline__ void p2_phase(const Frame& F) {
    for (int u = F.wg; u < NCH; u += F.nwg) conv_unit(F, u);
    asm volatile("" ::: "memory");
    for (int u = (F.wg + ((NCH + F.nwg - 1) / F.nwg) * F.nwg - NCH) % F.nwg; u < NCH * 4; u += F.nwg) kv_unit(F, u >> 2, u & 3);
    __syncthreads();
}
__device__ __forceinline__ void p4_phase(const Frame& F) { for (int u = F.wg; u < NCH * 2; u += F.nwg) ret_unit(F, u >> 1, u & 1); __syncthreads(); }
struct Args { const float* in[19]; float* out; unsigned char* ws; int ph_lo, ph_hi; };
template <class Fn> __device__ __forceinline__ void gemm_both(const Frame& F, const bf16* A, const bf16* Bt, int N, int K, const Fn& fn) {
    pg8::Gemm g{A, Bt, MMAIN, N, K}; pg8::StaticOrder S; S.init(MMAIN, N, F.nwg, F.wg);
    EpiAd<Fn> E{fn};
    pg8::gemm_phase<EpiAd<Fn>, pg8::StaticOrder, true, true>(F.lds, g, S, E);
    __syncthreads();
    tail_gemm(F, A, Bt, K, N, fn);
}
__global__ void __launch_bounds__(NT, 2) hymba_fwd(Args args) {
    extern __shared__ __attribute__((aligned(16))) unsigned char lds_raw[];
    cg::grid_group grid = cg::this_grid();
    Frame F;
    F.lds = (LAS unsigned char*)lds_raw;
    F.tid = threadIdx.x; F.lane = F.tid & 63; F.wave = __builtin_amdgcn_readfirstlane(F.tid >> 6); F.wg = blockIdx.x; F.nwg = gridDim.x;
    F.xp = args.in[0]; F.xs = args.in[1]; F.state = args.in[2]; F.cache = args.in[3]; F.meta = args.in[4]; F.g_pre_mix = args.in[5]; F.w_in = args.in[6];
    F.gn_g = args.in[7]; F.gn_b = args.in[8]; F.dw_w = args.in[9]; F.dw_b = args.in[10]; F.cln_g = args.in[11]; F.cln_b = args.in[12]; F.w_out = args.in[13];
    F.g_post_mix = args.in[14]; F.g_pre_mlp = args.in[15]; F.w_mi = args.in[16]; F.w_mo = args.in[17]; F.g_post_mlp = args.in[18];
    F.out = args.out;
    unsigned char* ws = args.ws;
    F.Win_t = (bf16*)(ws + WS_WIN); F.Wout_t = (bf16*)(ws + WS_WOUT); F.Wmi_t = (bf16*)(ws + WS_WMI); F.Wmo_t = (bf16*)(ws + WS_WMO);
    F.BufA = (bf16*)(ws + WS_BUFA); F.BufB = (bf16*)(ws + WS_BUFB); F.Ub = F.BufB; F.Gb = F.BufB + (size_t)R * 512;
    F.Qb = (bf16*)(ws + WS_Q); F.Kb = (bf16*)(ws + WS_K); F.Vb = (bf16*)(ws + WS_V); F.KVt = (float*)(ws + WS_KVT); F.St = (bf16*)(ws + WS_ST); F.HID = (bf16*)(ws + WS_HID);
    volatile LAS unsigned* MISC = (volatile LAS unsigned*)(F.lds + 131072 + 1024);
    if (F.tid < 16) MISC[F.tid] = 0u;
    __syncthreads();
    const XcdBarrier bar = xcd_barrier_post((unsigned*)ws + 4096, MISC + 8);
    const int lo = args.ph_lo, hi = args.ph_hi;
#ifndef PH_MASK
#define PH_MASK 0x3ff
#endif
#define IN(k) (((PH_MASK >> (k)) & 1) && lo <= (k) && (k) < hi)
#ifndef USE_CG_SYNC
#define USE_CG_SYNC 0
#endif
#if USE_CG_SYNC
#define GRID_SYNC() grid.sync()
#else
#define GRID_SYNC() xcd_barrier(bar)
#endif
#ifndef REP_MASK
#define REP_MASK 0
#endif
#ifndef SYNC_REP
#define SYNC_REP 1
#endif
#define SEAM(k) do { if (IN(k) && IN((k) + 1)) { for (int r_ = 0; r_ < SYNC_REP; ++r_) GRID_SYNC(); } } while (0)
#define REPEAT(k, stmt) do { if (IN(k)) { stmt; if ((REP_MASK >> (k)) & 1) { GRID_SYNC(); stmt; } } } while (0)
    REPEAT(0, p0_prologue(F));
    SEAM(0);
    REPEAT(1, gemm_both(F, F.BufA, F.Win_t, NIN, D, (FProj{F.Qb, F.Kb, F.Vb, F.Gb, F.Ub})));
    SEAM(1);
    REPEAT(2, p2_phase(F));
    SEAM(2);
    REPEAT(3, scan_phase(F));
    SEAM(3);
    REPEAT(4, p4_phase(F));
    SEAM(4);
    REPEAT(5, gemm_both(F, F.BufA, F.Wout_t, D, D, (FStore{F.BufB, D})));
    SEAM(5);
    REPEAT(6, rowpass1(F));
    SEAM(6);
    REPEAT(7, gemm_both(F, F.BufA, F.Wmi_t, FF, D, (FRelu2{F.HID, FF})));
    SEAM(7);
    REPEAT(8, gemm_both(F, F.HID, F.Wmo_t, D, FF, (FStore{F.BufA, D})));
    SEAM(8);
    if (IN(9)) rowpass2(F);
#undef IN
#undef SEAM
}

#ifndef N_LAUNCH_PER_PHASE
#define N_LAUNCH_PER_PHASE 0
#endif
extern "C" void kernel_launch(void* const* d_in, const int* in_sizes, int n_in, void* d_out, int out_size, void* d_ws, size_t ws_size, hipStream_t stream) {
    static int grid = 0;
    if (grid == 0) {
        if (n_in != 19 || ws_size < WS_END) { fprintf(stderr, "kernel_launch: unexpected problem (n_in %d, ws %zu)\n", n_in, ws_size); grid = -1; return; }
        int dev = 0, cus = 0, per_cu = 0;
        hipGetDevice(&dev); hipDeviceGetAttribute(&cus, hipDeviceAttributeMultiprocessorCount, dev);
        if (hipFuncSetAttribute((const void*)hymba_fwd, hipFuncAttributeMaxDynamicSharedMemorySize, LDS_BYTES) != hipSuccess) { fprintf(stderr, "kernel_launch: hipFuncSetAttribute failed\n"); grid = -1; return; }
        if (hipOccupancyMaxActiveBlocksPerMultiprocessor(&per_cu, (const void*)hymba_fwd, NT, LDS_BYTES) != hipSuccess || per_cu < 1) { fprintf(stderr, "kernel_launch: occupancy query failed (%d)\n", per_cu); (void)hipGetLastError(); per_cu = 1; }
        grid = cus * per_cu;
        fprintf(stderr, "kernel_launch: %d CUs x %d = grid %d\n", cus, per_cu, grid);
    }
    if (grid < 0) return;
    if (hipMemsetAsync(d_ws, 0, 65536, stream) != hipSuccess) { fprintf(stderr, "kernel_launch: memset failed\n"); return; }
    Args a{};
    for (int i = 0; i < 19; ++i) a.in[i] = (const float*)d_in[i];
    a.out = (float*)d_out; a.ws = (unsigned char*)d_ws;
#if N_LAUNCH_PER_PHASE
    for (int p = 0; p < 10; ++p) { a.ph_lo = p; a.ph_hi = p + 1; hipLaunchKernelGGL(hymba_fwd, dim3(grid), dim3(NT), LDS_BYTES, stream, a); }
#else
    a.ph_lo = 0; a.ph_hi = 10;
    void* kargs[] = {&a};
    hipError_t e = hipLaunchCooperativeKernel((const void*)hymba_fwd, dim3(grid), dim3(NT), kargs, LDS_BYTES, stream);
    if (e != hipSuccess) fprintf(stderr, "kernel_launch: cooperative launch failed: %s (grid %d)\n", hipGetErrorString(e), grid);
#endif
}
```

```cpp
#include <hip/hip_runtime.h>
#include <hip/hip_cooperative_groups.h>
#include <cstdio>
#include <cstdint>
namespace cg = cooperative_groups;
namespace pg8 {
#define PG8_LAS __attribute__((address_space(3)))
typedef unsigned short bf16_t;
typedef short bf16x8 __attribute__((ext_vector_type(8)));
typedef float f32x4 __attribute__((ext_vector_type(4)));
typedef unsigned u32x4 __attribute__((ext_vector_type(4)));
constexpr int BM = 256, BK = 64, HALF = 128, HTB = HALF * BK * 2  , STAGE_BYTES = 8 * HTB, NXCD = 8, WGM = 8;

__host__ __device__ __forceinline__ int lds_byte(int r, int c) { const int st = (r >> 4) * 2 + (c >> 5), rr = r & 15, cc = c & 31, ob = rr * 64 + cc * 2; return st * 1024 + (ob ^ (((ob >> 9) & 1) << 5)); }
__host__ __device__ __forceinline__ void stage_rc(int b, int& R, int& C) { const int st = b / 1024, sb = b % 1024, swz = sb ^ (((sb >> 9) & 1) << 5); R = (st >> 1) * 16 + swz / 64; C = (st & 1) * 32 + (swz % 64) / 2; }
__host__ __device__ __forceinline__ int perm32(int rho) { const int n = rho >> 4, i = rho & 15; return 8 * (i >> 2) + 4 * n + (i & 3); }

struct Unit { int pm, pn; };
struct Gemm { const bf16_t* A; const bf16_t* Bt; int M, N, K; };

struct StaticOrder {
    int nM, nN, nwg, G, c;
    __host__ __device__ void init(int M, int N, int G_, int c_) { nM = M / BM; nN = N / BM; nwg = nM * nN; G = G_; c = c_; }
    __host__ __device__ bool next(int i, Unit& u) const {
        const long L = (long)i * G + c; if (L >= nwg) return false;
        int wgid = (int)L; { const int q = nwg / NXCD, r = nwg % NXCD, xcd = wgid % NXCD, off = wgid / NXCD; wgid = (xcd < r ? xcd * (q + 1) : r * (q + 1) + (xcd - r) * q) + off; }
        const int nig = WGM * nN, gid = wgid / nig, fm = gid * WGM, gsz = (nM - fm) < WGM ? (nM - fm) : WGM;
        u.pm = fm + ((wgid % nig) % gsz); u.pn = (wgid % nig) / gsz; return true;
    }
    __device__ __forceinline__ void a_ready(const Unit&) const {}
    __device__ __forceinline__ void done(const Unit&) const {}
};

__device__ __forceinline__ unsigned cvt_pk_bf16(float lo, float hi) { unsigned r; asm volatile("v_cvt_pk_bf16_f32 %0, %1, %2" : "=v"(r) : "v"(lo), "v"(hi)); return r; }
template <class Epi, class Sched, bool ALIGN_EPI = false, bool SP2 = false>
__device__ __forceinline__ void gemm_phase(PG8_LAS unsigned char* lds, const Gemm g, const Sched& S, const Epi& E) {
    const int tid = threadIdx.x, wid = __builtin_amdgcn_readfirstlane(tid >> 6), lane = tid & 63, wr = wid >> 2, wc = wid & 3, fr = lane & 15, fq = lane >> 4;
    const int K = g.K, nt = K / BK;
    unsigned voffA[2], voffB[2];
#pragma unroll
    for (int i = 0; i < 2; ++i) { int R, C; stage_rc(tid * 16 + i * 8192, R, C); const int Rb = Epi::PERM ? ((R & ~31) + perm32(R & 31)) : R;
        voffA[i] = (unsigned)(R * K + C) * 2u; voffB[i] = (unsigned)(Rb * K + C) * 2u; }
    const size_t kstep = (size_t)(BK * 2);
    const size_t hstep = (size_t)HALF * K * 2;
    const size_t tstep = 2 * hstep;
    const unsigned ldsw = (unsigned)wid * 1024u;
    const int aoff = lds_byte(wr * 64 + fr, fq * 8), boff = lds_byte(wc * 32 + fr, fq * 8);
#define PG8_SA(b, h) (((b) * 2 + (h)) * HTB)
#define PG8_SB(b, h) ((4 + (b) * 2 + (h)) * HTB)
#define PG8_STAGE(bufoff, gbase, voff) do { _Pragma("unroll") for (int _i = 0; _i < 2; ++_i) \
        __builtin_amdgcn_global_load_lds((const unsigned*)((const char*)(gbase) + (voff)[_i]), (PG8_LAS unsigned*)(lds + (bufoff) + ldsw + _i * 8192), 16, 0, 0); } while (0)
#define PG8_LDA(dst, b, h) do { _Pragma("unroll") for (int m = 0; m < 4; ++m) _Pragma("unroll") for (int k = 0; k < 2; ++k) dst[m][k] = *(const PG8_LAS bf16x8*)(lds + PG8_SA(b, h) + aoff + m * 2048 + k * 1024); } while (0)
#define PG8_LDB(dst, b, h) do { _Pragma("unroll") for (int n = 0; n < 2; ++n) _Pragma("unroll") for (int k = 0; k < 2; ++k) dst[n][k] = *(const PG8_LAS bf16x8*)(lds + PG8_SB(b, h) + boff + n * 2048 + k * 1024); } while (0)
#define PG8_MMA(ai, bj, At, Bt) do { __builtin_amdgcn_s_setprio(1); _Pragma("unroll") for (int m = 0; m < 4; ++m) _Pragma("unroll") for (int n = 0; n < 2; ++n) _Pragma("unroll") for (int k = 0; k < 2; ++k) \
        acc[ai][bj][m][n] = __builtin_amdgcn_mfma_f32_16x16x32_bf16(Bt[n][k], At[m][k], acc[ai][bj][m][n], 0, 0, 0); __builtin_amdgcn_s_setprio(0); } while (0)
#define PG8_WAIT_V(n) asm volatile("s_waitcnt vmcnt(" #n ")" ::: "memory")
#define PG8_WAIT_L(n) asm volatile("s_waitcnt lgkmcnt(" #n ")" ::: "memory")
#define PG8_BAR __builtin_amdgcn_s_barrier()
#define PG8_SCHED __builtin_amdgcn_sched_barrier(0)
    Unit cur, nxt; int ui = 0;
    if (!S.next(0, cur)) return;
    f32x4 acc[2][2][4][2];
#pragma unroll
    for (int a = 0; a < 2; ++a)
#pragma unroll
        for (int b = 0; b < 2; ++b)
#pragma unroll
            for (int m = 0; m < 4; ++m)
#pragma unroll
                for (int n = 0; n < 2; ++n) acc[a][b][m][n] = (f32x4){0.f, 0.f, 0.f, 0.f};
    bf16x8 At[4][2], B0[2][2], B1[2][2];
    const char* cA = (const char*)g.A + (size_t)cur.pm * tstep; const char* cB = (const char*)g.Bt + (size_t)cur.pn * tstep;
    S.a_ready(cur);
    if constexpr (SP2) {
        PG8_STAGE(PG8_SB(0, 0), cB, voffB); PG8_STAGE(PG8_SB(0, 1), cB + hstep, voffB); PG8_STAGE(PG8_SA(0, 0), cA, voffA); PG8_STAGE(PG8_SA(0, 1), cA + hstep, voffA);
        if (wr == 1) PG8_BAR;
        PG8_WAIT_V(2); PG8_BAR;
        PG8_STAGE(PG8_SB(1, 0), cB + kstep, voffB); PG8_STAGE(PG8_SA(1, 0), cA + kstep, voffA); PG8_STAGE(PG8_SB(1, 1), cB + hstep + kstep, voffB);
        PG8_WAIT_V(6); PG8_BAR;
    } else {
        PG8_STAGE(PG8_SB(0, 0), cB, voffB); PG8_STAGE(PG8_SA(0, 0), cA, voffA); PG8_STAGE(PG8_SB(0, 1), cB + hstep, voffB); PG8_STAGE(PG8_SA(0, 1), cA + hstep, voffA);
        if (wr == 1) PG8_BAR;
        PG8_WAIT_V(4); PG8_BAR;
        PG8_STAGE(PG8_SB(1, 0), cB + kstep, voffB); PG8_STAGE(PG8_SA(1, 0), cA + kstep, voffA); PG8_STAGE(PG8_SB(1, 1), cB + hstep + kstep, voffB);
        PG8_WAIT_V(6); PG8_BAR;
    }
    for (;;) {
        const bool has_next = S.next(ui + 1, nxt);
        const char* nA = has_next ? (const char*)g.A + (size_t)nxt.pm * tstep : cA; const char* nB = has_next ? (const char*)g.Bt + (size_t)nxt.pn * tstep : cB;
        for (int t = 0; t < nt; t += 2) {
            const bool last = (t == nt - 2);
            const char* a1 = cA + (size_t)(t + 1) * kstep;
            const char* a2 = last ? nA : cA + (size_t)(t + 2) * kstep; const char* b2 = last ? nB : cB + (size_t)(t + 2) * kstep;
            const char* a3 = a2 + kstep; const char* b3 = b2 + kstep;
            if (last && has_next) S.a_ready(nxt);
            if constexpr (SP2) {
            PG8_LDB(B0, 0, 0); PG8_LDB(B1, 0, 1); PG8_SCHED; PG8_LDA(At, 0, 0); PG8_STAGE(PG8_SA(1, 1), a1 + hstep, voffA);
            PG8_WAIT_V(8); PG8_WAIT_L(0); PG8_BAR; PG8_MMA(0, 0, At, B0); PG8_MMA(0, 1, At, B1); PG8_BAR; PG8_SCHED;
            PG8_LDA(At, 0, 1); PG8_STAGE(PG8_SB(0, 0), b2, voffB); PG8_STAGE(PG8_SB(0, 1), b2 + hstep, voffB); PG8_STAGE(PG8_SA(0, 0), a2, voffA);
            PG8_WAIT_V(8); PG8_WAIT_L(0); PG8_BAR; PG8_MMA(1, 0, At, B0); PG8_MMA(1, 1, At, B1); PG8_BAR; PG8_SCHED;
            PG8_LDB(B0, 1, 0); PG8_LDB(B1, 1, 1); PG8_SCHED; PG8_LDA(At, 1, 0); PG8_STAGE(PG8_SA(0, 1), a2 + hstep, voffA);
            PG8_WAIT_V(8); PG8_WAIT_L(0); PG8_BAR; PG8_MMA(0, 0, At, B0); PG8_MMA(0, 1, At, B1); PG8_BAR; PG8_SCHED;
            PG8_LDA(At, 1, 1); PG8_STAGE(PG8_SB(1, 0), b3, voffB); PG8_STAGE(PG8_SB(1, 1), b3 + hstep, voffB); PG8_STAGE(PG8_SA(1, 0), a3, voffA);
            PG8_WAIT_V(8); PG8_WAIT_L(0); PG8_BAR; PG8_MMA(1, 0, At, B0); PG8_MMA(1, 1, At, B1); PG8_BAR; PG8_SCHED;
            } else {
            PG8_LDB(B0, 0, 0); PG8_SCHED; PG8_LDA(At, 0, 0); PG8_STAGE(PG8_SA(1, 1), a1 + hstep, voffA);
            PG8_WAIT_L(8); PG8_BAR; PG8_WAIT_L(0); PG8_MMA(0, 0, At, B0); PG8_BAR; PG8_SCHED;
            PG8_LDB(B1, 0, 1); PG8_STAGE(PG8_SB(0, 0), b2, voffB);
            PG8_BAR; PG8_WAIT_L(0); PG8_MMA(0, 1, At, B1); PG8_BAR;
            PG8_LDA(At, 0, 1); PG8_STAGE(PG8_SA(0, 0), a2, voffA);
            PG8_BAR; PG8_WAIT_L(0); PG8_MMA(1, 0, At, B0); PG8_BAR; PG8_SCHED;
            PG8_STAGE(PG8_SB(0, 1), b2 + hstep, voffB);
            PG8_WAIT_V(6); PG8_BAR; PG8_MMA(1, 1, At, B1); PG8_BAR;
            PG8_LDB(B0, 1, 0); PG8_SCHED; PG8_LDA(At, 1, 0); PG8_STAGE(PG8_SA(0, 1), a2 + hstep, voffA);
            PG8_WAIT_L(8); PG8_BAR; PG8_WAIT_L(0); PG8_MMA(0, 0, At, B0); PG8_BAR; PG8_SCHED;
            PG8_LDB(B1, 1, 1); PG8_STAGE(PG8_SB(1, 0), b3, voffB);
            PG8_BAR; PG8_WAIT_L(0); PG8_MMA(0, 1, At, B1); PG8_BAR;
            PG8_LDA(At, 1, 1); PG8_STAGE(PG8_SA(1, 0), a3, voffA);
            PG8_BAR; PG8_WAIT_L(0); PG8_MMA(1, 0, At, B0); PG8_BAR; PG8_SCHED;
            PG8_STAGE(PG8_SB(1, 1), b3 + hstep, voffB);
            PG8_WAIT_V(6); PG8_BAR; PG8_MMA(1, 1, At, B1); PG8_BAR;
            }
        }
        if constexpr (ALIGN_EPI) { if (wr == 0) PG8_BAR; }
        if constexpr (!Epi::AFTER_DRAIN) { E(acc, cur, wr, wc, fr, fq); S.done(cur); }
        if (!has_next) break;
#pragma unroll
        for (int a = 0; a < 2; ++a)
#pragma unroll
            for (int b = 0; b < 2; ++b)
#pragma unroll
                for (int m = 0; m < 4; ++m)
#pragma unroll
                    for (int n = 0; n < 2; ++n) acc[a][b][m][n] = (f32x4){0.f, 0.f, 0.f, 0.f};
        cur = nxt; cA = nA; cB = nB; ++ui;
        if constexpr (ALIGN_EPI) { if (wr == 1) PG8_BAR; }
    }
    PG8_WAIT_V(0);
    if constexpr (!ALIGN_EPI) { if (wr == 0) PG8_BAR; }
    PG8_BAR;
    if constexpr (Epi::AFTER_DRAIN) { E.fused(acc, cur, wr, wc, fr, fq, lds, wid, lane); S.done(cur); }
#undef PG8_SA
#undef PG8_SB
#undef PG8_STAGE
#undef PG8_LDA
#undef PG8_LDB
#undef PG8_MMA
#undef PG8_WAIT_V
#undef PG8_WAIT_L
#undef PG8_BAR
#undef PG8_SCHED
}
}
#define GAS __attribute__((address_space(1)))
#define LAS __attribute__((address_space(3)))
typedef unsigned short bf16;
typedef unsigned v4u __attribute__((ext_vector_type(4)));
typedef unsigned v2u __attribute__((ext_vector_type(2)));
typedef float f32x4 __attribute__((ext_vector_type(4)));
typedef short bf16x8 __attribute__((ext_vector_type(8)));

constexpr int NWAVES = 8, NT = 512;
constexpr int D = 1024, NIN = 3072, FF = 4096, HD = 128, NH = 4, RW = 512, CW = 512, CK = 31;
constexpr int MMAIN = 16384, ROW_META = 16384, ROW_SMP = 16400, NREAL = 16912, R = 16960, MTAIL = R - MMAIN;
constexpr int NCH = 289;
constexpr float EPS = 1e-6f;
constexpr size_t MiB = 1u << 20;
constexpr size_t WS_WIN = 1 * MiB, WS_WOUT = 7 * MiB, WS_WMI = 9 * MiB, WS_WMO = 17 * MiB;
constexpr size_t WS_BUFA = 25 * MiB;
constexpr size_t WS_BUFB = 59 * MiB;
constexpr size_t WS_Q = 93 * MiB, WS_K = 110 * MiB, WS_V = 127 * MiB;
constexpr size_t WS_KVT = 144 * MiB;
constexpr size_t WS_ST = 209 * MiB;
constexpr size_t WS_HID = 93 * MiB;
constexpr size_t WS_COS = 246 * MiB, WS_SIN = 251 * MiB;
constexpr size_t WS_END = 256 * MiB;
static_assert((size_t)R * 1024 * 2 <= 34 * MiB && (size_t)R * 512 * 2 <= 17 * MiB && (size_t)257 * 4 * 16384 * 4 <= 65 * MiB && (size_t)NCH * 4 * 16384 * 2 <= 37 * MiB && WS_HID + (size_t)R * 4096 * 2 <= WS_END, "ws map");
constexpr size_t O_YP = 0, O_YS = 16777216, O_SP = 17301504, O_CP = 17367040, O_SS = 17382400, O_CS = 19479552;
constexpr int LDS_BYTES = 147456;

__constant__ double c_invturn[64] = {0.15915494309189535, 0.13782250260398285, 0.11934937021124886, 0.10335229661843406, 0.08949940160889101, 0.07750328875537406, 0.06711508300522726, 0.058119267441876246, 0.050329212104487035, 0.04358330210530733, 0.03774158471741977, 0.032682865872357, 0.0283021958306234, 0.024508691862069852, 0.02122365276477766, 0.018378926105679667, 0.015915494309189534, 0.013782250260398284, 0.011934937021124886, 0.010335229661843406, 0.008949940160889102, 0.0077503288755374055, 0.006711508300522725, 0.005811926744187624, 0.005032921210448704, 0.004358330210530733, 0.003774158471741977, 0.0032682865872356993, 0.00283021958306234, 0.002450869186206985, 0.0021223652764777662, 0.0018378926105679667, 0.0015915494309189536, 0.0013782250260398288, 0.0011934937021124885, 0.0010335229661843405, 0.0008949940160889102, 0.0007750328875537405, 0.0006711508300522726, 0.0005811926744187624, 0.0005032921210448703, 0.0004358330210530733, 0.00037741584717419774, 0.0003268286587235699, 0.00028302195830623395, 0.00024508691862069854, 0.0002122365276477766, 0.00018378926105679666, 0.00015915494309189535, 0.00013782250260398286, 0.00011934937021124886, 0.00010335229661843406, 8.949940160889102e-05, 7.750328875537406e-05, 6.711508300522725e-05, 5.811926744187624e-05, 5.0329212104487035e-05, 4.358330210530732e-05, 3.774158471741978e-05, 3.2682865872357e-05, 2.8302195830623396e-05, 2.4508691862069852e-05, 2.122365276477766e-05, 1.8378926105679668e-05};

__device__ __forceinline__ float lg2gamma(int h) { return h == 0 ? -0.04580368961312479f : h == 1 ? -0.02272007650008353f : h == 2 ? -0.011315313227834146f : -0.005646563141142063f; }
__device__ __forceinline__ float ex2(float x) { return __builtin_amdgcn_exp2f(x); }
__device__ __forceinline__ unsigned f2bf(float f) { unsigned u = __builtin_bit_cast(unsigned, f); return (u + 0x7fffu + ((u >> 16) & 1u)) >> 16; }
__device__ __forceinline__ unsigned pk2(float lo, float hi) { return f2bf(lo) | (f2bf(hi) << 16); }
__device__ __forceinline__ float bflo(unsigned w) { return __builtin_bit_cast(float, w << 16); }
__device__ __forceinline__ float bfhi(unsigned w) { return __builtin_bit_cast(float, w & 0xffff0000u); }
__device__ __forceinline__ float bf1(bf16 h) { return __builtin_bit_cast(float, (unsigned)h << 16); }
__device__ __forceinline__ float sigmoidf_(float x) { return 1.0f / (1.0f + __expf(-x)); }
__device__ __forceinline__ float siluf_(float x) { return x / (1.0f + __expf(-x)); }
__device__ __forceinline__ float wave_sum(float v) {
#pragma unroll
    for (int o = 1; o < 64; o <<= 1) v += __shfl_xor(v, o);
    return v;
}
__device__ __forceinline__ int rowpos(int row) { return row < ROW_META ? 16 + row : (row < ROW_SMP ? row - ROW_META : 4112 + ((row - ROW_SMP) & 15)); }
__device__ __forceinline__ int dorig(int dp) { return (dp >> 1) + 64 * (dp & 1); }
__device__ __forceinline__ int win_src_col(int n) {
    if (n < 1024) return (n & ~127) + dorig(n & 127);
    if (n < 2048) return n;
    const int c = (n - 2048) >> 1; return (n & 1) ? 2560 + c : 2048 + c;
}

struct Frame {
    LAS unsigned char* lds;
    int tid, lane, wave, wg, nwg;
    const float *xp, *xs, *state, *cache, *meta, *g_pre_mix, *w_in, *gn_g, *gn_b, *dw_w, *dw_b, *cln_g, *cln_b, *w_out, *g_post_mix, *g_pre_mlp, *w_mi, *w_mo, *g_post_mlp;
    float* out;
    bf16 *Win_t, *Wout_t, *Wmi_t, *Wmo_t, *BufA, *BufB, *Ub, *Gb, *Qb, *Kb, *Vb, *St, *HID;
    float *KVt, *cosT, *sinT;
};
__device__ __forceinline__ const float* xrow(const Frame& F, int row) {
    if (row < ROW_META) return F.xp + (size_t)row * D;
    if (row < ROW_SMP) return F.meta + (size_t)(row - ROW_META) * D;
    return F.xs + (size_t)(row - ROW_SMP) * D;
}

struct FStore { bf16* O; int ldc;
    __device__ __forceinline__ void operator()(int row, int col, f32x4 v0, f32x4 v1) const {
        v4u w; w.x = pg8::cvt_pk_bf16(v0[0], v0[1]); w.y = pg8::cvt_pk_bf16(v0[2], v0[3]); w.z = pg8::cvt_pk_bf16(v1[0], v1[1]); w.w = pg8::cvt_pk_bf16(v1[2], v1[3]);
        *(v4u*)(O + (size_t)row * ldc + col) = w; } };
struct FRelu2 { bf16* O; int ldc;
    __device__ __forceinline__ void operator()(int row, int col, f32x4 v0, f32x4 v1) const {
#pragma unroll
        for (int t = 0; t < 4; ++t) { float a = fmaxf(v0[t], 0.f), b = fmaxf(v1[t], 0.f); v0[t] = a * a; v1[t] = b * b; }
        v4u w; w.x = pg8::cvt_pk_bf16(v0[0], v0[1]); w.y = pg8::cvt_pk_bf16(v0[2], v0[3]); w.z = pg8::cvt_pk_bf16(v1[0], v1[1]); w.w = pg8::cvt_pk_bf16(v1[2], v1[3]);
        *(v4u*)(O + (size_t)row * ldc + col) = w; } };
struct FProj { bf16 *Q, *K, *V, *G, *U; const float *cosT, *sinT;
    __device__ __forceinline__ void operator()(int row, int col, f32x4 v0, f32x4 v1) const {
        const int reg = col >> 9;
        float x[8] = {v0[0], v0[1], v0[2], v0[3], v1[0], v1[1], v1[2], v1[3]};
        if (reg < 2) {
            const int cc = col & 511, d0 = (cc & 127) >> 1;
            const int pos = rowpos(row);
            const float sc = reg == 1 ? 0.08838834764831845f : 1.0f;
            const f32x4 c4 = *(const f32x4*)(cosT + (size_t)pos * 64 + d0), s4 = *(const f32x4*)(sinT + (size_t)pos * 64 + d0);
#pragma unroll
            for (int t = 0; t < 4; ++t) {
                const float x1 = x[2 * t], x2 = x[2 * t + 1];
                x[2 * t] = (x1 * c4[t] - x2 * s4[t]) * sc; x[2 * t + 1] = (x2 * c4[t] + x1 * s4[t]) * sc;
            }
            v4u w; w.x = pg8::cvt_pk_bf16(x[0], x[1]); w.y = pg8::cvt_pk_bf16(x[2], x[3]); w.z = pg8::cvt_pk_bf16(x[4], x[5]); w.w = pg8::cvt_pk_bf16(x[6], x[7]);
            *(v4u*)((reg == 0 ? Q : K) + (size_t)row * 512 + cc) = w;
        } else if (reg < 4) {
            const int cc = col & 511;
            if (reg == 3) {
#pragma unroll
                for (int t = 0; t < 8; ++t) x[t] = siluf_(x[t]);
            }
            v4u w; w.x = pg8::cvt_pk_bf16(x[0], x[1]); w.y = pg8::cvt_pk_bf16(x[2], x[3]); w.z = pg8::cvt_pk_bf16(x[4], x[5]); w.w = pg8::cvt_pk_bf16(x[6], x[7]);
            *(v4u*)((reg == 2 ? V : G) + (size_t)row * 512 + cc) = w;
        } else {
            const int c0 = (col - 2048) >> 1;
            float u[4];
#pragma unroll
            for (int t = 0; t < 4; ++t) u[t] = x[2 * t] * sigmoidf_(x[2 * t + 1]);
            v2u w; w.x = pg8::cvt_pk_bf16(u[0], u[1]); w.y = pg8::cvt_pk_bf16(u[2], u[3]);
            *(v2u*)(U + (size_t)row * 512 + c0) = w;
        }
    } };
template <class Fn> struct EpiAd {
    static constexpr bool PERM = true, AFTER_DRAIN = false; Fn f;
    __device__ __forceinline__ void operator()(const f32x4 (&acc)[2][2][4][2], const pg8::Unit& u, int wr, int wc, int fr, int fq) const {
        const int row0 = u.pm * 256 + wr * 64 + fr, col0 = u.pn * 256 + wc * 32 + 8 * fq;
#pragma unroll
        for (int ai = 0; ai < 2; ++ai)
#pragma unroll
            for (int m = 0; m < 4; ++m)
#pragma unroll
                for (int bj = 0; bj < 2; ++bj) f(row0 + ai * 128 + m * 16, col0 + bj * 128, acc[ai][bj][m][0], acc[ai][bj][m][1]);
    } };

template <class Fn>
__device__ __forceinline__ void tail_gemm(const Frame& F, const bf16* A, const bf16* Bt, const int K, const int N, const Fn& f) {
    const int lane = F.lane, wave = F.wave, fr = lane & 15, fq = lane >> 4;
    const int nunits = (MTAIL / 64) * (N / 64), kw = K / 8;
    LAS f32x4* red = (LAS f32x4*)F.lds;
    for (int u = F.wg; u < nunits; u += F.nwg) {
        const int nb = u / (MTAIL / 64), mb = u % (MTAIL / 64), rb = MMAIN + 64 * mb, cb = 64 * nb;
        f32x4 acc[4][2][2];
#pragma unroll
        for (int i = 0; i < 16; ++i) acc[i >> 2][(i >> 1) & 1][i & 1] = (f32x4){0.f, 0.f, 0.f, 0.f};
        const bf16* ap = A + (size_t)(rb + fr) * K + wave * kw + 8 * fq;
        const bf16* bp = Bt + (size_t)(cb + 8 * (fr >> 2) + (fr & 3)) * K + wave * kw + 8 * fq;
#pragma unroll 4
        for (int ks = 0; ks < kw / 32; ++ks) {
            bf16x8 a[4], b[2][2];
#pragma unroll
            for (int mi = 0; mi < 4; ++mi) a[mi] = *(const bf16x8*)(ap + (size_t)mi * 16 * K + ks * 32);
#pragma unroll
            for (int g = 0; g < 2; ++g)
#pragma unroll
                for (int n = 0; n < 2; ++n) b[g][n] = *(const bf16x8*)(bp + (size_t)(32 * g + 4 * n) * K + ks * 32);
#pragma unroll
            for (int mi = 0; mi < 4; ++mi)
#pragma unroll
                for (int g = 0; g < 2; ++g)
#pragma unroll
                    for (int n = 0; n < 2; ++n) acc[mi][g][n] = __builtin_amdgcn_mfma_f32_16x16x32_bf16(b[g][n], a[mi], acc[mi][g][n], 0, 0, 0);
        }
#pragma unroll
        for (int i = 0; i < 16; ++i) red[(wave * 16 + i) * 64 + lane] = acc[i >> 2][(i >> 1) & 1][i & 1];
        __syncthreads();
        {
            const int mi = wave >> 1, g = wave & 1;
            f32x4 v0 = (f32x4){0.f, 0.f, 0.f, 0.f}, v1 = v0;
#pragma unroll
            for (int w = 0; w < 8; ++w) { v0 += red[(w * 16 + (mi * 2 + g) * 2 + 0) * 64 + lane]; v1 += red[(w * 16 + (mi * 2 + g) * 2 + 1) * 64 + lane]; }
            f(rb + 16 * mi + fr, cb + 32 * g + 8 * fq, v0, v1);
        }
        __syncthreads();
    }
}
#define XB_TMO      128
#define XB_XCNT(j)  (256  + 64 * (j))
#define XB_XSUB(j)  (1280 + 64 * (j))
#define XB_XGEN(j)  (2304 + 64 * (j))
#define XB_TOP      3328
#define XB_TOPGEN   3392
#define XCD_BAR_WORDS 3456
#define XB_SPIN_CAP (1u << 18)

__device__ __forceinline__ unsigned xb_ld(unsigned* p)              { return __hip_atomic_load(p, __ATOMIC_RELAXED, __HIP_MEMORY_SCOPE_AGENT); }
__device__ __forceinline__ unsigned xb_add(unsigned* p, unsigned v) { return __hip_atomic_fetch_add(p, v, __ATOMIC_RELAXED, __HIP_MEMORY_SCOPE_AGENT); }
__device__ __forceinline__ unsigned xb_xcc_id() { return (unsigned)__builtin_amdgcn_s_getreg((3 << 11) | 20) & 0xFu; }
#define XB_SPIN(cond, bar) do { unsigned _sp = 0; while (cond) { __builtin_amdgcn_s_sleep(1); \
    if ((++_sp & 255u) == 0u) { if (xb_ld(&(bar)[XB_TMO])) break; if (_sp > XB_SPIN_CAP) { atomicAdd(&(bar)[XB_TMO], 1u); break; } } } } while (0)

struct XcdBarrier {
    unsigned* bar; unsigned x;
    volatile LAS unsigned* st;
};

__device__ __forceinline__ XcdBarrier xcd_barrier_post(unsigned* bar, volatile LAS unsigned* st) {
    XcdBarrier b; b.bar = bar; b.x = xb_xcc_id(); b.st = st;
    if (threadIdx.x == 0) (void)xb_add(&bar[XB_XCNT(b.x)], 1u);
    return b;
}
__device__ __forceinline__ void xcd_barrier_complete(unsigned* bar, unsigned x, unsigned& nloc, unsigned& nx) {
    const unsigned G = gridDim.x * gridDim.y * gridDim.z;
    unsigned sum, cnt, mine, sp = 0u;
    for (;;) {
        sum = 0u; cnt = 0u; mine = 0u;
#pragma unroll
        for (unsigned j = 0; j < 16; ++j) { const unsigned c = xb_ld(&bar[XB_XCNT(j)]); sum += c; cnt += (c > 0u) ? 1u : 0u; mine = (j == x) ? c : mine; }
        if (sum == G) break;
        __builtin_amdgcn_s_sleep(1);
        if ((++sp & 255u) == 0u) { if (xb_ld(&bar[XB_TMO])) break; if (sp > XB_SPIN_CAP) { atomicAdd(&bar[XB_TMO], 1u); break; } }
    }
    nloc = mine > 0u ? mine : 1u; nx = cnt > 0u ? cnt : 1u;
}

__device__ __forceinline__ void xcd_barrier(const XcdBarrier& b) {
    asm volatile("s_waitcnt vmcnt(0)" ::: "memory");
    __syncthreads();
    if (threadIdx.x == 0) {
        unsigned* bar = b.bar;
        __builtin_amdgcn_s_waitcnt(0);
        unsigned nloc = b.st[0], nx = b.st[1];
        if (nloc == 0u) { xcd_barrier_complete(bar, b.x, nloc, nx); b.st[0] = nloc; b.st[1] = nx; }
        const unsigned old = xb_add(&bar[XB_XSUB(b.x)], 1u);
        const unsigned gen = old / nloc;
        if (old + 1u == (gen + 1u) * nloc) {
            __builtin_amdgcn_fence(__ATOMIC_RELEASE, "agent");
            asm volatile("s_waitcnt vmcnt(0)" ::: "memory");
            const unsigned og = xb_add(&bar[XB_TOP], 1u);
            const unsigned tg = og / nx;
            if (og + 1u == (tg + 1u) * nx) xb_add(&bar[XB_TOPGEN], 1u);
            else XB_SPIN(xb_ld(&bar[XB_TOPGEN]) == tg, bar);
            __builtin_amdgcn_fence(__ATOMIC_ACQUIRE, "agent");
            xb_add(&bar[XB_XGEN(b.x)], 1u);
            asm volatile("s_waitcnt vmcnt(0)" ::: "memory");
        } else {
            XB_SPIN(xb_ld(&bar[XB_XGEN(b.x)]) == gen, bar);
            __builtin_amdgcn_fence(__ATOMIC_ACQUIRE, "agent");
            asm volatile("s_waitcnt vmcnt(0)" ::: "memory");
        }
    }
    __syncthreads();
}

template <bool PERMIN>
__device__ __forceinline__ void p0_transpose_item(const float* W, int K, int N, bf16* WT, LAS float* scr, int item, int lane) {
    const int nblk = N / 32, kb = item / nblk, nb = item % nblk, k0 = 64 * kb, n0 = 32 * nb;
    const int nsrc = PERMIN ? win_src_col(n0 + (lane & 31)) : n0 + (lane & 31);
#pragma unroll 8
    for (int i = 0; i < 32; ++i) { const int kk = 2 * i + (lane >> 5); scr[kk * 33 + (lane & 31)] = W[(size_t)(k0 + kk) * N + nsrc]; }
    asm volatile("s_waitcnt lgkmcnt(0)" ::: "memory");
    const int c = lane & 7;
#pragma unroll
    for (int j = 0; j < 4; ++j) { const int n = (lane >> 3) + 8 * j; const LAS float* s = scr + (8 * c) * 33 + n;
        v4u o; o.x = pk2(s[0 * 33], s[1 * 33]); o.y = pk2(s[2 * 33], s[3 * 33]); o.z = pk2(s[4 * 33], s[5 * 33]); o.w = pk2(s[6 * 33], s[7 * 33]);
        *(v4u*)(WT + (size_t)(n0 + n) * K + k0 + 8 * c) = o; }
    asm volatile("s_waitcnt lgkmcnt(0)" ::: "memory");
}
__device__ __forceinline__ void rms_row_to_bf16(const float* xr_, const float* g, bf16* orow, int lane) {
    const f32x4* xr = (const f32x4*)xr_ + lane; const f32x4* gr = (const f32x4*)g + lane;
    f32x4 v[4]; float s = 0.f;
#pragma unroll
    for (int j = 0; j < 4; ++j) { v[j] = xr[64 * j]; s += (v[j].x * v[j].x + v[j].y * v[j].y) + (v[j].z * v[j].z + v[j].w * v[j].w); }
    const float rs = 1.0f / sqrtf(wave_sum(s) * (1.f / D) + EPS);
    unsigned long long* o8 = (unsigned long long*)orow + lane;
#pragma unroll
    for (int j = 0; j < 4; ++j) { const f32x4 gg = gr[64 * j];
        o8[64 * j] = (unsigned long long)pk2(v[j].x * rs * gg.x, v[j].y * rs * gg.y) | ((unsigned long long)pk2(v[j].z * rs * gg.z, v[j].w * rs * gg.w) << 32); }
}
__device__ __forceinline__ void p0_prologue(const Frame& F) {
    LAS float* scr = (LAS float*)(F.lds + F.wave * 16384);
    const int gw = F.wg * NWAVES + F.wave, NGW = F.nwg * NWAVES;
    constexpr int I_IN = (D / 64) * (NIN / 32), I_O = (D / 64) * (D / 32), I_1 = (D / 64) * (FF / 32), I_2 = (FF / 64) * (D / 32);
    constexpr int NITEMS = I_IN + I_O + I_1 + I_2;
    for (int it = gw; it < NITEMS; it += NGW) {
        int r = it;
        if (r < I_IN) { p0_transpose_item<true>(F.w_in, D, NIN, F.Win_t, scr, r, F.lane); continue; } r -= I_IN;
        if (r < I_O) { p0_transpose_item<false>(F.w_out, D, D, F.Wout_t, scr, r, F.lane); continue; } r -= I_O;
        if (r < I_1) { p0_transpose_item<false>(F.w_mi, D, FF, F.Wmi_t, scr, r, F.lane); continue; } r -= I_1;
        p0_transpose_item<false>(F.w_mo, FF, D, F.Wmo_t, scr, r, F.lane);
    }
    for (int i = F.wg * NT + F.tid; i < 16400 * 64; i += F.nwg * NT) {
        double tu = (double)(i >> 6) * c_invturn[i & 63]; tu -= __builtin_rint(tu);
        const float f = (float)tu; F.cosT[i] = __builtin_amdgcn_cosf(f); F.sinT[i] = __builtin_amdgcn_sinf(f);
    }
    for (int m = gw; m < R; m += NGW) {
        if (m < NREAL) rms_row_to_bf16(xrow(F, m), F.g_pre_mix, F.BufA + (size_t)m * D, F.lane);
        else { unsigned long long* o8 = (unsigned long long*)(F.BufA + (size_t)m * D) + F.lane;
#pragma unroll
            for (int j = 0; j < 4; ++j) o8[64 * j] = 0ull; }
    }
}

__device__ __forceinline__ void chunk_geom(int cid, int& row0, int& off) {
    if (cid == 0) { row0 = ROW_META - 48; off = 48; }
    else if (cid <= 256) { row0 = (cid - 1) * 64; off = 0; }
    else { row0 = ROW_SMP + (cid - 257) * 16 - 48; off = 48; }
}

constexpr int TS = 130;
__device__ __forceinline__ bf16x8 gather_col(const LAS bf16* T, int r0, int c) {
    bf16x8 v;
#pragma unroll
    for (int t = 0; t < 8; ++t) v[t] = (short)T[(r0 + t) * TS + c];
    return v;
}
__device__ __forceinline__ void lds_put16(LAS bf16* T, int r, int c8, v4u w) {
    LAS unsigned* p = (LAS unsigned*)(T + r * TS + c8);
    p[0] = w.x; p[1] = w.y; p[2] = w.z; p[3] = w.w;
}
__device__ __forceinline__ void kv_unit(const Frame& F, int cid, int h) {
    LAS bf16* Ks = (LAS bf16*)F.lds; LAS bf16* Vs = Ks + 64 * TS;
    int row0, off; chunk_geom(cid, row0, off);
    const float lg = lg2gamma(h);
    __syncthreads();
#pragma unroll
    for (int i = 0; i < 2; ++i) {
        const int p = F.tid + NT * i, j = p >> 4, seg = p & 15;
        v4u kw = (v4u){0u, 0u, 0u, 0u}, vw = kw;
        if (j >= off) {
            kw = *(const v4u*)(F.Kb + (size_t)(row0 + j) * 512 + h * 128 + seg * 8);
            vw = *(const v4u*)(F.Vb + (size_t)(row0 + j) * 512 + h * 128 + seg * 8);
            const float w = ex2(lg * (float)(63 - j));
            kw.x = pk2(bflo(kw.x) * w, bfhi(kw.x) * w); kw.y = pk2(bflo(kw.y) * w, bfhi(kw.y) * w); kw.z = pk2(bflo(kw.z) * w, bfhi(kw.z) * w); kw.w = pk2(bflo(kw.w) * w, bfhi(kw.w) * w);
        }
        lds_put16(Ks, j, seg * 8, kw); lds_put16(Vs, j, seg * 8, vw);
    }
    __syncthreads();
    const int fr = F.lane & 15, fq = F.lane >> 4, e0 = 16 * F.wave;
    f32x4 acc[8];
#pragma unroll
    for (int db = 0; db < 8; ++db) acc[db] = (f32x4){0.f, 0.f, 0.f, 0.f};
#pragma unroll
    for (int ks = 0; ks < 2; ++ks) {
        const bf16x8 vf = gather_col(Vs, 32 * ks + 8 * fq, e0 + fr);
#pragma unroll
        for (int db = 0; db < 8; ++db) { const bf16x8 kf = gather_col(Ks, 32 * ks + 8 * fq, 16 * db + fr);
            acc[db] = __builtin_amdgcn_mfma_f32_16x16x32_bf16(kf, vf, acc[db], 0, 0, 0); asm volatile("" ::: "memory"); }
    }
    if (cid <= 256) {
        float* o = F.KVt + ((size_t)(cid * 4 + h) * 128 + e0 + fr) * 128 + 4 * fq;
#pragma unroll
        for (int db = 0; db < 8; ++db) *(f32x4*)(o + 16 * db) = acc[db];
    } else {
        const int b = cid - 257; const float g16 = ex2(lg * 16.0f);
        const size_t base = (size_t)(b * 4 + h) * 16384;
#pragma unroll
        for (int db = 0; db < 8; ++db)
#pragma unroll
            for (int r = 0; r < 4; ++r) { const size_t idx = base + (size_t)dorig(16 * db + 4 * fq + r) * 128 + e0 + fr;
                F.out[O_SS + idx] = g16 * F.state[idx] + acc[db][r]; }
#pragma unroll
        for (int i = 0; i < 4; ++i) {
            const int p = F.tid + NT * i, seg = p >> 7, e = p & 127;
            float s[8];
#pragma unroll
            for (int t = 0; t < 8; ++t) s[t] = F.state[base + (size_t)dorig(8 * seg + t) * 128 + e];
            v4u w; w.x = pk2(s[0], s[1]); w.y = pk2(s[2], s[3]); w.z = pk2(s[4], s[5]); w.w = pk2(s[6], s[7]);
            *(v4u*)(F.St + ((size_t)(cid * 4 + h) * 128 + e) * 128 + 8 * seg) = w;
        }
    }
}

template <int RPW>
__device__ __forceinline__ void conv_compute(const Frame& F, const LAS bf16* us, const LAS bf16* wts, int rowbase) {
    const int c0 = F.lane * 8, r0 = F.wave * RPW;
    float acc[RPW][8];
    { const f32x4 b0 = *(const f32x4*)(F.dw_b + c0), b1 = *(const f32x4*)(F.dw_b + c0 + 4);
#pragma unroll
      for (int o = 0; o < RPW; ++o) { acc[o][0] = b0.x; acc[o][1] = b0.y; acc[o][2] = b0.z; acc[o][3] = b0.w; acc[o][4] = b1.x; acc[o][5] = b1.y; acc[o][6] = b1.z; acc[o][7] = b1.w; } }
#pragma unroll 1
    for (int tap = 0; tap < CK; ++tap) {
        const v4u ww = *(const LAS v4u*)(wts + tap * 512 + c0);
        const float w[8] = {bflo(ww.x), bfhi(ww.x), bflo(ww.y), bfhi(ww.y), bflo(ww.z), bfhi(ww.z), bflo(ww.w), bfhi(ww.w)};
#pragma unroll
        for (int o = 0; o < RPW; ++o) {
            const v4u uu = *(const LAS v4u*)(us + (r0 + o + tap) * 512 + c0);
            acc[o][0] += w[0] * bflo(uu.x); acc[o][1] += w[1] * bfhi(uu.x); acc[o][2] += w[2] * bflo(uu.y); acc[o][3] += w[3] * bfhi(uu.y);
            acc[o][4] += w[4] * bflo(uu.z); acc[o][5] += w[5] * bfhi(uu.z); acc[o][6] += w[6] * bflo(uu.w); acc[o][7] += w[7] * bfhi(uu.w);
        }
    }
    const f32x4 g0 = *(const f32x4*)(F.cln_g + c0), g1 = *(const f32x4*)(F.cln_g + c0 + 4), b0 = *(const f32x4*)(F.cln_b + c0), b1 = *(const f32x4*)(F.cln_b + c0 + 4);
    const float g[8] = {g0.x, g0.y, g0.z, g0.w, g1.x, g1.y, g1.z, g1.w}, bb[8] = {b0.x, b0.y, b0.z, b0.w, b1.x, b1.y, b1.z, b1.w};
#pragma unroll
    for (int o = 0; o < RPW; ++o) {
        float s = 0.f;
#pragma unroll
        for (int t = 0; t < 8; ++t) s += acc[o][t];
        const float mu = wave_sum(s) * (1.f / CW);
        float q = 0.f;
#pragma unroll
        for (int t = 0; t < 8; ++t) { const float dlt = acc[o][t] - mu; q += dlt * dlt; }
        const float rs = 1.0f / sqrtf(wave_sum(q) * (1.f / CW) + EPS);
        float y[8];
#pragma unroll
        for (int t = 0; t < 8; ++t) y[t] = siluf_((acc[o][t] - mu) * rs * g[t] + bb[t]);
        v4u w; w.x = pk2(y[0], y[1]); w.y = pk2(y[2], y[3]); w.z = pk2(y[4], y[5]); w.w = pk2(y[6], y[7]);
        *(v4u*)(F.BufA + (size_t)(rowbase + r0 + o) * D + 512 + c0) = w;
    }
}
__device__ __forceinline__ void conv_unit(const Frame& F, int cid) {
    LAS bf16* us = (LAS bf16*)F.lds;
    LAS bf16* wts = us + 94 * 512;
    const int L = (cid >= 1 && cid <= 256) ? 64 : 16;
    const int rowbase = cid == 0 ? ROW_META : (cid <= 256 ? (cid - 1) * 64 : ROW_SMP + (cid - 257) * 16);
    __syncthreads();
    for (int p = F.tid; p < (30 + L) * 64; p += NT) {
        const int x = p >> 6, seg = p & 63;
        v4u w = (v4u){0u, 0u, 0u, 0u};
        if (x >= 30) w = *(const v4u*)(F.Ub + (size_t)(rowbase + x - 30) * 512 + seg * 8);
        else if (cid > 256) { const float* s = F.cache + ((size_t)(cid - 257) * 30 + x) * 512 + seg * 8; const f32x4 a = *(const f32x4*)s, b = *(const f32x4*)(s + 4);
            w.x = pk2(a.x, a.y); w.y = pk2(a.z, a.w); w.z = pk2(b.x, b.y); w.w = pk2(b.z, b.w); }
        else if (cid >= 1) { const int pos = 16 + (cid - 1) * 64 - 30 + x;
            if (pos >= 0) { const int row = pos < 16 ? ROW_META + pos : pos - 16; w = *(const v4u*)(F.Ub + (size_t)row * 512 + seg * 8); } }
        *(LAS v4u*)(us + x * 512 + seg * 8) = w;
    }
    for (int p = F.tid; p < CK * 64; p += NT) { const float* s = F.dw_w + (size_t)p * 8; const f32x4 a = *(const f32x4*)s, b = *(const f32x4*)(s + 4);
        v4u w; w.x = pk2(a.x, a.y); w.y = pk2(a.z, a.w); w.z = pk2(b.x, b.y); w.w = pk2(b.z, b.w); *(LAS v4u*)(wts + p * 8) = w; }
    __syncthreads();
    if (L == 64) conv_compute<8>(F, us, wts, rowbase); else conv_compute<2>(F, us, wts, rowbase);
    if (cid == 256) {
        for (int i = F.tid; i < 30 * 512; i += NT) F.out[O_CP + i] = bf1(us[64 * 512 + i]);
    } else if (cid > 256) {
        const int b = cid - 257;
        for (int i = F.tid; i < 30 * 512; i += NT) { const int r = i >> 9;
            F.out[O_CS + (size_t)b * 30 * 512 + i] = r < 14 ? F.cache[((size_t)b * 30 + 16) * 512 + i] : bf1(us[16 * 512 + i]); }
    }
}

__device__ __forceinline__ void scan_phase(const Frame& F) {
    if (F.tid >= 256) return;
    for (int el = F.wg * 256 + F.tid; el < 65536; el += F.nwg * 256) {
        const int h = el >> 14, within = el & 16383, e = within >> 7, dp = within & 127;
        const float a = ex2(lg2gamma(h) * 64.0f);
        float s = 0.f;
        const float* kv = F.KVt + (size_t)h * 16384 + within; bf16* st = F.St + (size_t)h * 16384 + within;
        for (int c0 = 0; c0 < 256; c0 += 32) {
            float v[32];
#pragma unroll
            for (int i = 0; i < 32; ++i) v[i] = kv[(size_t)(c0 + i) * 65536];
#pragma unroll
            for (int i = 0; i < 32; ++i) { st[(size_t)(c0 + i) * 65536] = (bf16)f2bf(s); s = a * s + v[i]; }
        }
        st[(size_t)256 * 65536] = (bf16)f2bf(s); s = a * s + kv[(size_t)256 * 65536];
        F.out[O_SP + (size_t)(h * 128 + dorig(dp)) * 128 + e] = s;
    }
}

constexpr int PS = 72;
__device__ __forceinline__ void ret_unit(const Frame& F, int cid, int hp) {
    LAS bf16* Vs = (LAS bf16*)F.lds;
    LAS bf16* Pw = (LAS bf16*)(F.lds + 2 * 64 * TS * 2) + F.wave * 16 * PS;
    int row0, off; chunk_geom(cid, row0, off);
    __syncthreads();
#pragma unroll
    for (int i = 0; i < 4; ++i) {
        const int p = F.tid + NT * i, hh = p >> 10, j = (p >> 4) & 63, seg = p & 15;
        v4u vw = (v4u){0u, 0u, 0u, 0u};
        if (j >= off) vw = *(const v4u*)(F.Vb + (size_t)(row0 + j) * 512 + (2 * hp + hh) * 128 + seg * 8);
        lds_put16(Vs + hh * 64 * TS, j, seg * 8, vw);
    }
    __syncthreads();
    const int fr = F.lane & 15, fq = F.lane >> 4, hh = F.wave >> 2, ib = F.wave & 3, h = 2 * hp + hh;
    const int i_loc = 16 * ib + fr;
    const bool ivalid = i_loc >= off;
    const float lg = lg2gamma(h);
    bf16x8 qf[4];
#pragma unroll
    for (int ks = 0; ks < 4; ++ks) { qf[ks] = (bf16x8){0, 0, 0, 0, 0, 0, 0, 0};
        if (ivalid) qf[ks] = *(const bf16x8*)(F.Qb + (size_t)(row0 + i_loc) * 512 + h * 128 + 32 * ks + 8 * fq); }
    f32x4 sc[4];
#pragma unroll
    for (int jb = 0; jb < 4; ++jb) { sc[jb] = (f32x4){0.f, 0.f, 0.f, 0.f};
        const int j = 16 * jb + fr;
#pragma unroll
        for (int ks = 0; ks < 4; ++ks) { bf16x8 kf = (bf16x8){0, 0, 0, 0, 0, 0, 0, 0};
            if (j >= off) kf = *(const bf16x8*)(F.Kb + (size_t)(row0 + j) * 512 + h * 128 + 32 * ks + 8 * fq);
            sc[jb] = __builtin_amdgcn_mfma_f32_16x16x32_bf16(kf, qf[ks], sc[jb], 0, 0, 0); } }
#pragma unroll
    for (int jb = 0; jb < 4; ++jb) { float pv[4];
#pragma unroll
        for (int r = 0; r < 4; ++r) { const int j = 16 * jb + 4 * fq + r; const int dd = i_loc > j ? i_loc - j : j - i_loc; pv[r] = sc[jb][r] * ex2(lg * (float)dd); }
        v2u w; w.x = pk2(pv[0], pv[1]); w.y = pk2(pv[2], pv[3]);
        *(LAS v2u*)(Pw + fr * PS + 16 * jb + 4 * fq) = w; }
    asm volatile("s_waitcnt lgkmcnt(0)" ::: "memory");
    f32x4 ao[8], ai[8];
#pragma unroll
    for (int eb = 0; eb < 8; ++eb) { ao[eb] = (f32x4){0.f, 0.f, 0.f, 0.f}; ai[eb] = ao[eb]; }
#pragma unroll
    for (int ks = 0; ks < 2; ++ks) {
        const bf16x8 pf = *(const LAS bf16x8*)(Pw + fr * PS + 32 * ks + 8 * fq);
#pragma unroll
        for (int eb = 0; eb < 8; ++eb) { const bf16x8 vf = gather_col(Vs + hh * 64 * TS, 32 * ks + 8 * fq, 16 * eb + fr);
            ao[eb] = __builtin_amdgcn_mfma_f32_16x16x32_bf16(vf, pf, ao[eb], 0, 0, 0); }
    }
    const bf16* st = F.St + ((size_t)(cid * 4 + h) * 128 + fr) * 128 + 8 * fq;
#pragma unroll
    for (int eb = 0; eb < 8; ++eb)
#pragma unroll
        for (int ks = 0; ks < 4; ++ks) { const bf16x8 sf = *(const bf16x8*)(st + (size_t)(16 * eb) * 128 + 32 * ks);
            ai[eb] = __builtin_amdgcn_mfma_f32_16x16x32_bf16(sf, qf[ks], ai[eb], 0, 0, 0); }
    const float din = ex2(lg * (float)(i_loc - off + 1));
    float s = 0.f;
#pragma unroll
    for (int eb = 0; eb < 8; ++eb) { ao[eb] = ao[eb] + ai[eb] * din; s += (ao[eb][0] + ao[eb][1]) + (ao[eb][2] + ao[eb][3]); }
    s += __shfl_xor(s, 16); s += __shfl_xor(s, 32);
    const float mu = s * (1.f / HD);
    float q = 0.f;
#pragma unroll
    for (int eb = 0; eb < 8; ++eb) { const f32x4 dlt = ao[eb] - mu; q += (dlt[0] * dlt[0] + dlt[1] * dlt[1]) + (dlt[2] * dlt[2] + dlt[3] * dlt[3]); }
    q += __shfl_xor(q, 16); q += __shfl_xor(q, 32);
    const float rs = 1.0f / sqrtf(q * (1.f / HD) + EPS);
    if (ivalid) {
        const int row = row0 + i_loc;
#pragma unroll
        for (int eb = 0; eb < 8; ++eb) { const int c = h * 128 + 16 * eb + 4 * fq;
            const f32x4 gg = *(const f32x4*)(F.gn_g + c), gb = *(const f32x4*)(F.gn_b + c);
            const v2u sg = *(const v2u*)(F.Gb + (size_t)row * 512 + c);
            const f32x4 rn = (ao[eb] - mu) * rs * gg + gb;
            v2u w; w.x = pk2(rn[0] * bflo(sg.x), rn[1] * bfhi(sg.x)); w.y = pk2(rn[2] * bflo(sg.y), rn[3] * bfhi(sg.y));
            *(v2u*)(F.BufA + (size_t)row * D + c) = w; }
    }
}

__device__ __forceinline__ void rowpass1(const Frame& F) {
    const int gw = F.wg * NWAVES + F.wave, NGW = F.nwg * NWAVES;
    for (int row = gw; row < NREAL; row += NGW) {
        const float* xr = xrow(F, row);
        float m[16], x[16]; float ss = 0.f;
#pragma unroll
        for (int i = 0; i < 2; ++i) { const int c = 512 * i + 8 * F.lane;
            const v4u w = *(const v4u*)(F.BufB + (size_t)row * D + c);
            m[8 * i + 0] = bflo(w.x); m[8 * i + 1] = bfhi(w.x); m[8 * i + 2] = bflo(w.y); m[8 * i + 3] = bfhi(w.y); m[8 * i + 4] = bflo(w.z); m[8 * i + 5] = bfhi(w.z); m[8 * i + 6] = bflo(w.w); m[8 * i + 7] = bfhi(w.w);
            const f32x4 a = *(const f32x4*)(xr + c), b = *(const f32x4*)(xr + c + 4);
            x[8 * i + 0] = a.x; x[8 * i + 1] = a.y; x[8 * i + 2] = a.z; x[8 * i + 3] = a.w; x[8 * i + 4] = b.x; x[8 * i + 5] = b.y; x[8 * i + 6] = b.z; x[8 * i + 7] = b.w; }
#pragma unroll
        for (int t = 0; t < 16; ++t) ss += m[t] * m[t];
        const float rs1 = 1.0f / sqrtf(wave_sum(ss) * (1.f / D) + EPS);
        float s2 = 0.f;
#pragma unroll
        for (int i = 0; i < 2; ++i) { const int c = 512 * i + 8 * F.lane; const f32x4 ga = *(const f32x4*)(F.g_post_mix + c), gb = *(const f32x4*)(F.g_post_mix + c + 4);
            const float g[8] = {ga.x, ga.y, ga.z, ga.w, gb.x, gb.y, gb.z, gb.w};
#pragma unroll
            for (int t = 0; t < 8; ++t) { x[8 * i + t] += m[8 * i + t] * rs1 * g[t]; s2 += x[8 * i + t] * x[8 * i + t]; } }
        const float rs2 = 1.0f / sqrtf(wave_sum(s2) * (1.f / D) + EPS);
        float* xo = row < ROW_META ? F.out + O_YP + (size_t)row * D : (row >= ROW_SMP ? F.out + O_YS + (size_t)(row - ROW_SMP) * D : nullptr);
#pragma unroll
        for (int i = 0; i < 2; ++i) { const int c = 512 * i + 8 * F.lane; const f32x4 ga = *(const f32x4*)(F.g_pre_mlp + c), gb = *(const f32x4*)(F.g_pre_mlp + c + 4);
            const float g[8] = {ga.x, ga.y, ga.z, ga.w, gb.x, gb.y, gb.z, gb.w};
            if (xo) { *(f32x4*)(xo + c) = (f32x4){x[8 * i], x[8 * i + 1], x[8 * i + 2], x[8 * i + 3]}; *(f32x4*)(xo + c + 4) = (f32x4){x[8 * i + 4], x[8 * i + 5], x[8 * i + 6], x[8 * i + 7]}; }
            v4u w; w.x = pk2(x[8 * i] * rs2 * g[0], x[8 * i + 1] * rs2 * g[1]); w.y = pk2(x[8 * i + 2] * rs2 * g[2], x[8 * i + 3] * rs2 * g[3]);
            w.z = pk2(x[8 * i + 4] * rs2 * g[4], x[8 * i + 5] * rs2 * g[5]); w.w = pk2(x[8 * i + 6] * rs2 * g[6], x[8 * i + 7] * rs2 * g[7]);
            *(v4u*)(F.BufA + (size_t)row * D + c) = w; }
    }
}
__device__ __forceinline__ void rowpass2(const Frame& F) {
    const int gw = F.wg * NWAVES + F.wave, NGW = F.nwg * NWAVES;
    for (int row = gw; row < NREAL; row += NGW) {
        if (row >= ROW_META && row < ROW_SMP) continue;
        float* xo = row < ROW_META ? F.out + O_YP + (size_t)row * D : F.out + O_YS + (size_t)(row - ROW_SMP) * D;
        float m[16]; float ss = 0.f;
#pragma unroll
        for (int i = 0; i < 2; ++i) { const int c = 512 * i + 8 * F.lane;
            const v4u w = *(const v4u*)(F.BufA + (size_t)row * D + c);
            m[8 * i + 0] = bflo(w.x); m[8 * i + 1] = bfhi(w.x); m[8 * i + 2] = bflo(w.y); m[8 * i + 3] = bfhi(w.y); m[8 * i + 4] = bflo(w.z); m[8 * i + 5] = bfhi(w.z); m[8 * i + 6] = bflo(w.w); m[8 * i + 7] = bfhi(w.w); }
#pragma unroll
        for (int t = 0; t < 16; ++t) ss += m[t] * m[t];
        const float rs = 1.0f / sqrtf(wave_sum(ss) * (1.f / D) + EPS);
#pragma unroll
        for (int i = 0; i < 2; ++i) { const int c = 512 * i + 8 * F.lane; const f32x4 ga = *(const f32x4*)(F.g_post_mlp + c), gb = *(const f32x4*)(F.g_post_mlp + c + 4);
            f32x4 a = *(const f32x4*)(xo + c), b = *(const f32x4*)(xo + c + 4);
            a.x += m[8 * i] * rs * ga.x; a.y += m[8 * i + 1] * rs * ga.y; a.z += m[8 * i + 2] * rs * ga.z; a.w += m[8 * i + 3] * rs * ga.w;
            b.x += m[8 * i + 4] * rs * gb.x; b.y += m[8 * i + 5] * rs * gb.y; b.z += m[8 * i + 6] * rs * gb.z; b.w += m[8 * i + 7] * rs * gb.w;
            *(f32x4*)(xo + c) = a; *(f32x4*)(xo + c + 4) = b; }
    }
}

__device__ __forceinline__ void p2_phase(const Frame& F) {
    for (int u = F.wg; u < NCH; u += F.nwg) conv_unit(F, u);
    asm volatile("" ::: "memory");
    for (int u = (F.wg + ((NCH + F.nwg - 1) / F.nwg) * F.nwg - NCH) % F.nwg; u < NCH * 4; u += F.nwg) kv_unit(F, u >> 2, u & 3);
    __syncthreads();
}
__device__ __forceinline__ void p4_phase(const Frame& F) { for (int u = F.wg; u < NCH * 2; u += F.nwg) ret_unit(F, u >> 1, u & 1); __syncthreads(); }
struct Args { const float* in[19]; float* out; unsigned char* ws; int ph_lo, ph_hi; };
template <class Fn> __device__ __forceinline__ void gemm_both(const Frame& F, const bf16* A, const bf16* Bt, int N, int K, const Fn& fn) {
    pg8::Gemm g{A, Bt, MMAIN, N, K}; pg8::StaticOrder S; S.init(MMAIN, N, F.nwg, F.wg);
    EpiAd<Fn> E{fn};
    pg8::gemm_phase<EpiAd<Fn>, pg8::StaticOrder, true, true>(F.lds, g, S, E);
    __syncthreads();
    tail_gemm(F, A, Bt, K, N, fn);
}
__global__ void __launch_bounds__(NT, 2) hymba_fwd(Args args) {
    extern __shared__ __attribute__((aligned(16))) unsigned char lds_raw[];
    cg::grid_group grid = cg::this_grid();
    Frame F;
    F.lds = (LAS unsigned char*)lds_raw;
    F.tid = threadIdx.x; F.lane = F.tid & 63; F.wave = __builtin_amdgcn_readfirstlane(F.tid >> 6); F.wg = blockIdx.x; F.nwg = gridDim.x;
    F.xp = args.in[0]; F.xs = args.in[1]; F.state = args.in[2]; F.cache = args.in[3]; F.meta = args.in[4]; F.g_pre_mix = args.in[5]; F.w_in = args.in[6];
    F.gn_g = args.in[7]; F.gn_b = args.in[8]; F.dw_w = args.in[9]; F.dw_b = args.in[10]; F.cln_g = args.in[11]; F.cln_b = args.in[12]; F.w_out = args.in[13];
    F.g_post_mix = args.in[14]; F.g_pre_mlp = args.in[15]; F.w_mi = args.in[16]; F.w_mo = args.in[17]; F.g_post_mlp = args.in[18];
    F.out = args.out;
    unsigned char* ws = args.ws;
    F.Win_t = (bf16*)(ws + WS_WIN); F.Wout_t = (bf16*)(ws + WS_WOUT); F.Wmi_t = (bf16*)(ws + WS_WMI); F.Wmo_t = (bf16*)(ws + WS_WMO);
    F.BufA = (bf16*)(ws + WS_BUFA); F.BufB = (bf16*)(ws + WS_BUFB); F.Ub = F.BufB; F.Gb = F.BufB + (size_t)R * 512;
    F.Qb = (bf16*)(ws + WS_Q); F.Kb = (bf16*)(ws + WS_K); F.Vb = (bf16*)(ws + WS_V); F.KVt = (float*)(ws + WS_KVT); F.St = (bf16*)(ws + WS_ST); F.HID = (bf16*)(ws + WS_HID); F.cosT = (float*)(ws + WS_COS); F.sinT = (float*)(ws + WS_SIN);
    volatile LAS unsigned* MISC = (volatile LAS unsigned*)(F.lds + 131072 + 1024);
    if (F.tid < 16) MISC[F.tid] = 0u;
    __syncthreads();
    const XcdBarrier bar = xcd_barrier_post((unsigned*)ws + 4096, MISC + 8);
    const int lo = args.ph_lo, hi = args.ph_hi;
#ifndef PH_MASK
#define PH_MASK 0x3ff
#endif
#define IN(k) (((PH_MASK >> (k)) & 1) && lo <= (k) && (k) < hi)
#ifndef USE_CG_SYNC
#define USE_CG_SYNC 0
#endif
#if USE_CG_SYNC
#define GRID_SYNC() grid.sync()
#else
#define GRID_SYNC() xcd_barrier(bar)
#endif
#ifndef REP_MASK
#define REP_MASK 0
#endif
#ifndef SYNC_REP
#define SYNC_REP 1
#endif
#define SEAM(k) do { if (IN(k) && IN((k) + 1)) { for (int r_ = 0; r_ < SYNC_REP; ++r_) GRID_SYNC(); } } while (0)
#define REPEAT(k, stmt) do { if (IN(k)) { stmt; if ((REP_MASK >> (k)) & 1) { GRID_SYNC(); stmt; } } } while (0)
    REPEAT(0, p0_prologue(F));
    SEAM(0);
    REPEAT(1, gemm_both(F, F.BufA, F.Win_t, NIN, D, (FProj{F.Qb, F.Kb, F.Vb, F.Gb, F.Ub, F.cosT, F.sinT})));
    SEAM(1);
    REPEAT(2, p2_phase(F));
    SEAM(2);
    REPEAT(3, scan_phase(F));
    SEAM(3);
    REPEAT(4, p4_phase(F));
    SEAM(4);
    REPEAT(5, gemm_both(F, F.BufA, F.Wout_t, D, D, (FStore{F.BufB, D})));
    SEAM(5);
    REPEAT(6, rowpass1(F));
    SEAM(6);
    REPEAT(7, gemm_both(F, F.BufA, F.Wmi_t, FF, D, (FRelu2{F.HID, FF})));
    SEAM(7);
    REPEAT(8, gemm_both(F, F.HID, F.Wmo_t, D, FF, (FStore{F.BufA, D})));
    SEAM(8);
    if (IN(9)) rowpass2(F);
#undef IN
#undef SEAM
}

#ifndef N_LAUNCH_PER_PHASE
#define N_LAUNCH_PER_PHASE 0
#endif
extern "C" void kernel_launch(void* const* d_in, const int* in_sizes, int n_in, void* d_out, int out_size, void* d_ws, size_t ws_size, hipStream_t stream) {
    static int grid = 0;
    if (grid == 0) {
        if (n_in != 19 || ws_size < WS_END) { fprintf(stderr, "kernel_launch: unexpected problem (n_in %d, ws %zu)\n", n_in, ws_size); grid = -1; return; }
        int dev = 0, cus = 0, per_cu = 0;
        hipGetDevice(&dev); hipDeviceGetAttribute(&cus, hipDeviceAttributeMultiprocessorCount, dev);
        if (hipFuncSetAttribute((const void*)hymba_fwd, hipFuncAttributeMaxDynamicSharedMemorySize, LDS_BYTES) != hipSuccess) { fprintf(stderr, "kernel_launch: hipFuncSetAttribute failed\n"); grid = -1; return; }
        if (hipOccupancyMaxActiveBlocksPerMultiprocessor(&per_cu, (const void*)hymba_fwd, NT, LDS_BYTES) != hipSuccess || per_cu < 1) { fprintf(stderr, "kernel_launch: occupancy query failed (%d)\n", per_cu); (void)hipGetLastError(); per_cu = 1; }
        grid = cus * per_cu;
        fprintf(stderr, "kernel_launch: %d CUs x %d = grid %d\n", cus, per_cu, grid);
    }
    if (grid < 0) return;
    if (hipMemsetAsync(d_ws, 0, 65536, stream) != hipSuccess) { fprintf(stderr, "kernel_launch: memset failed\n"); return; }
    Args a{};
    for (int i = 0; i < 19; ++i) a.in[i] = (const float*)d_in[i];
    a.out = (float*)d_out; a.ws = (unsigned char*)d_ws;
#if N_LAUNCH_PER_PHASE
    for (int p = 0; p < 10; ++p) { a.ph_lo = p; a.ph_hi = p + 1; hipLaunchKernelGGL(hymba_fwd, dim3(grid), dim3(NT), LDS_BYTES, stream, a); }
#else
    a.ph_lo = 0; a.ph_hi = 10;
    void* kargs[] = {&a};
    hipError_t e = hipLaunchCooperativeKernel((const void*)hymba_fwd, dim3(grid), dim3(NT), kargs, LDS_BYTES, stream);
    if (e != hipSuccess) fprintf(stderr, "kernel_launch: cooperative launch failed: %s (grid %d)\n", hipGetErrorString(e), grid);
#endif
}
```
